# Optimizing an MI355X kernel written in HIP

```python
import math
import jax, jax.numpy as jnp
from jax import lax
import numpy as np

D_MODEL = 1024
BATCH = 8
SEQ = 8192
DEPTH = 1

D_MIX = D_MODEL
D_SSM = D_MIX // 2
D_CONV = D_MIX - D_SSM
SSM_GROUP = 16
N_SSM_GROUPS = D_SSM // SSM_GROUP
SSM_STATE = 64
CONV_HEAD_DIM = 64
N_CONV_HEADS = D_CONV // CONV_HEAD_DIM
CONV_WIDTH = 3
D_IN_PROJ = D_SSM + 3 * D_CONV
D_FF = 4 * D_MODEL
RMS_EPS = 1e-6
DT_MIN = 1e-3
DT_MAX = 1e-1

kernel_name = "hymba_s5_shortconv_sandwich_block"


def rms_norm(x, g):
    xf = x.astype(jnp.float32)
    y = xf * lax.rsqrt(jnp.mean(xf * xf, axis=-1, keepdims=True) + RMS_EPS)
    return (y * g.astype(jnp.float32)).astype(x.dtype)


def _scan_combine(e1, e2):
    a1r, a1i, b1r, b1i = e1
    a2r, a2i, b2r, b2i = e2
    ar = a2r * a1r - a2i * a1i
    ai = a2r * a1i + a2i * a1r
    br = a2r * b1r - a2i * b1i + b2r
    bi = a2r * b1i + a2i * b1r + b2i
    return (ar, ai, br, bi)


def s5_group_mixer(u, lam_re, lam_im, log_dt, b_re, b_im, c_re, c_im, d_skip, w_glu):
    bsz, seq, _ = u.shape
    uf = u.astype(jnp.float32).reshape(bsz, seq, N_SSM_GROUPS, SSM_GROUP)
    lr = lam_re.astype(jnp.float32)
    li = lam_im.astype(jnp.float32)
    dt = jnp.exp(log_dt.astype(jnp.float32))[:, None]
    mag = jnp.exp(lr * dt)
    abr = mag * jnp.cos(li * dt)
    abi = mag * jnp.sin(li * dt)
    nr, ni = abr - 1.0, abi
    den = lr * lr + li * li
    coef_r = (nr * lr + ni * li) / den
    coef_i = (ni * lr - nr * li) / den
    br_ = b_re.astype(jnp.float32)
    bi_ = b_im.astype(jnp.float32)
    bbar_r = coef_r[..., None] * br_ - coef_i[..., None] * bi_
    bbar_i = coef_r[..., None] * bi_ + coef_i[..., None] * br_
    bu_r = jnp.einsum('blgh,gph->blgp', uf, bbar_r)
    bu_i = jnp.einsum('blgh,gph->blgp', uf, bbar_i)
    a_r = jnp.broadcast_to(abr, bu_r.shape)
    a_i = jnp.broadcast_to(abi, bu_i.shape)
    _, _, xr, xi = lax.associative_scan(_scan_combine, (a_r, a_i, bu_r, bu_i), axis=1)
    y = (jnp.einsum('blgp,ghp->blgh', xr, c_re.astype(jnp.float32))
         - jnp.einsum('blgp,ghp->blgh', xi, c_im.astype(jnp.float32)))
    y = y + d_skip.astype(jnp.float32) * uf
    y = jax.nn.gelu(y.reshape(bsz, seq, D_SSM))
    y = y * jax.nn.sigmoid(y @ w_glu.astype(jnp.float32))
    return y.astype(u.dtype)


def short_conv_mixer(h, b_gate, c_gate, conv_w):
    z = c_gate * h
    zp = jnp.pad(z, ((0, 0), (CONV_WIDTH - 1, 0), (0, 0)))
    conv = (conv_w[0] * zp[:, :-2] + conv_w[1] * zp[:, 1:-1] + conv_w[2] * zp[:, 2:])
    return b_gate * conv


def setup_inputs(seed: int = 0) -> dict:
    key = jax.random.key(seed)
    ks = jax.random.split(key, 24)
    f32 = jnp.float32
    L = DEPTH
    x = jax.random.normal(ks[0], (BATCH, SEQ, D_MODEL), f32)

    def gain(k, n):
        return 1.0 + 0.01 * jax.random.normal(k, (L, n), f32)

    n_idx = jnp.arange(SSM_STATE, dtype=f32)
    lam_re = -0.5 + 0.01 * jax.random.normal(ks[1], (L, N_SSM_GROUPS, SSM_STATE), f32)
    lam_im = math.pi * n_idx + 0.01 * jax.random.normal(ks[2], (L, N_SSM_GROUPS, SSM_STATE), f32)
    log_dt = jax.random.uniform(ks[3], (L, N_SSM_GROUPS), f32, math.log(DT_MIN), math.log(DT_MAX))
    b_scale = (2.0 * SSM_GROUP) ** -0.5
    c_scale = (2.0 * SSM_STATE) ** -0.5
    return {
        "x": x,
        "g_pre_mix": gain(ks[4], D_MODEL),
        "w_in": jax.random.normal(ks[5], (L, D_MODEL, D_IN_PROJ), f32) * D_MODEL ** -0.5,
        "lam_re": lam_re,
        "lam_im": lam_im,
        "log_dt": log_dt,
        "b_re": jax.random.normal(ks[6], (L, N_SSM_GROUPS, SSM_STATE, SSM_GROUP), f32) * b_scale,
        "b_im": jax.random.normal(ks[7], (L, N_SSM_GROUPS, SSM_STATE, SSM_GROUP), f32) * b_scale,
        "c_re": jax.random.normal(ks[8], (L, N_SSM_GROUPS, SSM_GROUP, SSM_STATE), f32) * c_scale,
        "c_im": jax.random.normal(ks[9], (L, N_SSM_GROUPS, SSM_GROUP, SSM_STATE), f32) * c_scale,
        "d_skip": jax.random.normal(ks[10], (L, N_SSM_GROUPS, SSM_GROUP), f32),
        "w_glu": jax.random.normal(ks[11], (L, D_SSM, D_SSM), f32) * D_SSM ** -0.5,
        "conv_w": jax.random.normal(ks[12], (L, CONV_WIDTH, D_CONV), f32) * CONV_WIDTH ** -0.5,
        "g_ssm_out": gain(ks[13], D_SSM),
        "g_conv_out": gain(ks[14], D_CONV),
        "w_out": jax.random.normal(ks[15], (L, D_MIX, D_MODEL), f32) * D_MIX ** -0.5,
        "g_post_mix": gain(ks[16], D_MODEL),
        "g_pre_mlp": gain(ks[17], D_MODEL),
        "w_up": jax.random.normal(ks[18], (L, D_MODEL, D_FF), f32) * D_MODEL ** -0.5,
        "w_down": jax.random.normal(ks[19], (L, D_FF, D_MODEL), f32) * D_FF ** -0.5,
        "g_post_mlp": gain(ks[20], D_MODEL),
    }


def reference(x, g_pre_mix, w_in, lam_re, lam_im, log_dt, b_re, b_im, c_re, c_im, d_skip,
              w_glu, conv_w, g_ssm_out, g_conv_out, w_out, g_post_mix, g_pre_mlp, w_up,
              w_down, g_post_mlp):
    for i in range(DEPTH):
        hn = rms_norm(x, g_pre_mix[i])
        proj = hn @ w_in[i]
        u_ssm = proj[..., :D_SSM]
        h_conv = proj[..., D_SSM:D_SSM + D_CONV]
        b_gate = proj[..., D_SSM + D_CONV:D_SSM + 2 * D_CONV]
        c_gate = proj[..., D_SSM + 2 * D_CONV:]
        y_ssm = s5_group_mixer(u_ssm, lam_re[i], lam_im[i], log_dt[i], b_re[i], b_im[i],
                               c_re[i], c_im[i], d_skip[i], w_glu[i])
        y_conv = short_conv_mixer(h_conv, b_gate, c_gate, conv_w[i])
        y = jnp.concatenate([rms_norm(y_ssm, g_ssm_out[i]),
                             rms_norm(y_conv, g_conv_out[i])], axis=-1)
        x = x + rms_norm(y @ w_out[i], g_post_mix[i])
        hn = rms_norm(x, g_pre_mlp[i])
        m = jnp.square(jax.nn.relu(hn @ w_up[i])) @ w_down[i]
        x = x + rms_norm(m, g_post_mlp[i])
    return x
```

```cpp
#define MK_MULTI 0
#include <hip/hip_runtime.h>
namespace pg8 {
#define PG8_LAS __attribute__((address_space(3)))
typedef unsigned short bf16_t;
typedef short bf16x8 __attribute__((ext_vector_type(8)));
typedef float f32x4 __attribute__((ext_vector_type(4)));
typedef unsigned u32x4 __attribute__((ext_vector_type(4)));
constexpr int BM = 256, BK = 64, HALF = 128, HTB = HALF * BK * 2  , STAGE_BYTES = 8 * HTB, NXCD = 8, WGM = 8;

__host__ __device__ __forceinline__ int lds_byte(int r, int c) { const int st = (r >> 4) * 2 + (c >> 5), rr = r & 15, cc = c & 31, ob = rr * 64 + cc * 2; return st * 1024 + (ob ^ (((ob >> 9) & 1) << 5)); }
__host__ __device__ __forceinline__ void stage_rc(int b, int& R, int& C) { const int st = b / 1024, sb = b % 1024, swz = sb ^ (((sb >> 9) & 1) << 5); R = (st >> 1) * 16 + swz / 64; C = (st & 1) * 32 + (swz % 64) / 2; }
__host__ __device__ __forceinline__ int perm32(int rho) { const int n = rho >> 4, i = rho & 15; return 8 * (i >> 2) + 4 * n + (i & 3); }

struct Unit { int pm, pn; };
struct Gemm { const bf16_t* A; const bf16_t* Bt; int M, N, K; };

struct StaticOrder {
    int nM, nN, nwg, G, c, nx;
    __host__ __device__ void init(int M, int N, int G_, int c_, int nx_ = NXCD) { nM = M / BM; nN = N / BM; nwg = nM * nN; G = G_; c = c_; nx = nx_; }
    __host__ __device__ bool next(int i, Unit& u) const {
        const long L = (long)i * G + c; if (L >= nwg) return false;
        int wgid = (int)L; { const int q = nwg / nx, r = nwg % nx, xcd = wgid % nx, off = wgid / nx; wgid = (xcd < r ? xcd * (q + 1) : r * (q + 1) + (xcd - r) * q) + off; }
        const int nig = WGM * nN, gid = wgid / nig, fm = gid * WGM, gsz = (nM - fm) < WGM ? (nM - fm) : WGM;
        u.pm = fm + ((wgid % nig) % gsz); u.pn = (wgid % nig) / gsz; return true;
    }
    __device__ __forceinline__ void a_ready(const Unit&) const {}
    __device__ __forceinline__ void done(const Unit&) const {}
};
__device__ __forceinline__ unsigned cvt_pk_bf16(float lo, float hi) { unsigned r; asm("v_cvt_pk_bf16_f32 %0, %1, %2" : "=v"(r) : "v"(lo), "v"(hi)); return r; }
template <class Epi, class Sched, bool ALIGN_EPI = false, bool SP2 = false, bool ABLK = false>
__device__ __forceinline__ void gemm_phase(PG8_LAS unsigned char* lds, const Gemm g, const Sched& S, const Epi& E) {
    const int tid = threadIdx.x, wid = __builtin_amdgcn_readfirstlane(tid >> 6), lane = tid & 63, wr = wid >> 2, wc = wid & 3, fr = lane & 15, fq = lane >> 4;
    const int K = g.K, nt = K / BK;
    unsigned voffA[2], voffB[2];
#pragma unroll
    for (int i = 0; i < 2; ++i) { int R, C; stage_rc(tid * 16 + i * 8192, R, C); const int Rb = Epi::PERM ? ((R & ~31) + perm32(R & 31)) : R;
        voffA[i] = ABLK ? (unsigned)(((((R >> 4) * (K >> 5) + (C >> 5)) * 16 + (R & 15)) * 32 + (C & 31))) * 2u : (unsigned)(R * K + C) * 2u; voffB[i] = (unsigned)(Rb * K + C) * 2u; }
    const size_t kstep = (size_t)(BK * 2);
    const size_t kstepA = ABLK ? (size_t)2048 : kstep;
    const size_t hstep = (size_t)HALF * K * 2;
    const size_t tstep = 2 * hstep;
    const unsigned ldsw = (unsigned)wid * 1024u;
    const int aoff = lds_byte(wr * 64 + fr, fq * 8), boff = lds_byte(wc * 32 + fr, fq * 8);
#define PG8_SA(b, h) (((b) * 2 + (h)) * HTB)
#define PG8_SB(b, h) ((4 + (b) * 2 + (h)) * HTB)
#define PG8_STAGE(bufoff, gbase, voff) do { _Pragma("unroll") for (int _i = 0; _i < 2; ++_i) \
        __builtin_amdgcn_global_load_lds((const unsigned*)((const char*)(gbase) + (voff)[_i]), (PG8_LAS unsigned*)(lds + (bufoff) + ldsw + _i * 8192), 16, 0, 0); } while (0)
#define PG8_LDA(dst, b, h) do { _Pragma("unroll") for (int m = 0; m < 4; ++m) _Pragma("unroll") for (int k = 0; k < 2; ++k) dst[m][k] = *(const PG8_LAS bf16x8*)(lds + PG8_SA(b, h) + aoff + m * 2048 + k * 1024); } while (0)
#define PG8_LDB(dst, b, h) do { _Pragma("unroll") for (int n = 0; n < 2; ++n) _Pragma("unroll") for (int k = 0; k < 2; ++k) dst[n][k] = *(const PG8_LAS bf16x8*)(lds + PG8_SB(b, h) + boff + n * 2048 + k * 1024); } while (0)
#define PG8_MMA(ai, bj, At, Bt) do { __builtin_amdgcn_s_setprio(1); _Pragma("unroll") for (int m = 0; m < 4; ++m) _Pragma("unroll") for (int n = 0; n < 2; ++n) _Pragma("unroll") for (int k = 0; k < 2; ++k) \
        acc[ai][bj][m][n] = __builtin_amdgcn_mfma_f32_16x16x32_bf16(Bt[n][k], At[m][k], acc[ai][bj][m][n], 0, 0, 0); __builtin_amdgcn_s_setprio(0); } while (0)
#define PG8_MMAQ(ai, bj, At, Bt) do { _Pragma("unroll") for (int m = 0; m < 4; ++m) _Pragma("unroll") for (int n = 0; n < 2; ++n) _Pragma("unroll") for (int k = 0; k < 2; ++k) \
        acc[ai][bj][m][n] = __builtin_amdgcn_mfma_f32_16x16x32_bf16(Bt[n][k], At[m][k], acc[ai][bj][m][n], 0, 0, 0); } while (0)
#define PG8_WAIT_V(n) asm volatile("s_waitcnt vmcnt(" #n ")" ::: "memory")
#define PG8_WAIT_L(n) asm volatile("s_waitcnt lgkmcnt(" #n ")" ::: "memory")
#define PG8_BAR __builtin_amdgcn_s_barrier()
#define PG8_SCHED __builtin_amdgcn_sched_barrier(0)
    Unit cur, nxt; int ui = 0;
    if (!S.next(0, cur)) return;
    f32x4 acc[2][2][4][2];
#pragma unroll
    for (int a = 0; a < 2; ++a)
#pragma unroll
        for (int b = 0; b < 2; ++b)
#pragma unroll
            for (int m = 0; m < 4; ++m)
#pragma unroll
                for (int n = 0; n < 2; ++n) acc[a][b][m][n] = (f32x4){0.f, 0.f, 0.f, 0.f};
    bf16x8 At[4][2], B0[2][2], B1[2][2];
    const char* cA = (const char*)g.A + (size_t)cur.pm * tstep; const char* cB = (const char*)g.Bt + (size_t)cur.pn * tstep;
    S.a_ready(cur);
    if constexpr (SP2) {
        PG8_STAGE(PG8_SB(0, 0), cB, voffB); PG8_STAGE(PG8_SB(0, 1), cB + hstep, voffB); PG8_STAGE(PG8_SA(0, 0), cA, voffA); PG8_STAGE(PG8_SA(0, 1), cA + hstep, voffA);
        if (wr == 1) PG8_BAR;
        PG8_WAIT_V(2); PG8_BAR;
        PG8_STAGE(PG8_SB(1, 0), cB + kstep, voffB); PG8_STAGE(PG8_SA(1, 0), cA + kstepA, voffA); PG8_STAGE(PG8_SB(1, 1), cB + hstep + kstep, voffB);
        PG8_WAIT_V(6); PG8_BAR;
    } else {
        PG8_STAGE(PG8_SB(0, 0), cB, voffB); PG8_STAGE(PG8_SA(0, 0), cA, voffA); PG8_STAGE(PG8_SB(0, 1), cB + hstep, voffB); PG8_STAGE(PG8_SA(0, 1), cA + hstep, voffA);
        if (wr == 1) PG8_BAR;
        PG8_WAIT_V(4); PG8_BAR;
        PG8_STAGE(PG8_SB(1, 0), cB + kstep, voffB); PG8_STAGE(PG8_SA(1, 0), cA + kstepA, voffA); PG8_STAGE(PG8_SB(1, 1), cB + hstep + kstep, voffB);
        PG8_WAIT_V(6); PG8_BAR;
    }
    for (;;) {
        const bool has_next = S.next(ui + 1, nxt);
        const char* nA = has_next ? (const char*)g.A + (size_t)nxt.pm * tstep : cA; const char* nB = has_next ? (const char*)g.Bt + (size_t)nxt.pn * tstep : cB;
        for (int t = 0; t < nt; t += 2) {
            const bool last = (t == nt - 2);
            const char* a1 = cA + (size_t)(t + 1) * kstepA;
            const char* a2 = last ? nA : cA + (size_t)(t + 2) * kstepA; const char* b2 = last ? nB : cB + (size_t)(t + 2) * kstep;
            const char* a3 = a2 + kstepA; const char* b3 = b2 + kstep;
            if (last && has_next) S.a_ready(nxt);
            if constexpr (SP2) {
            PG8_LDB(B0, 0, 0); PG8_LDB(B1, 0, 1); PG8_SCHED; PG8_LDA(At, 0, 0); PG8_STAGE(PG8_SA(1, 1), a1 + hstep, voffA);
            PG8_WAIT_V(8); PG8_WAIT_L(0); PG8_BAR; __builtin_amdgcn_s_setprio(1); PG8_MMAQ(0, 0, At, B0); PG8_MMAQ(0, 1, At, B1); __builtin_amdgcn_s_setprio(0); PG8_BAR; PG8_SCHED;
            PG8_LDA(At, 0, 1); PG8_STAGE(PG8_SB(0, 0), b2, voffB); PG8_STAGE(PG8_SB(0, 1), b2 + hstep, voffB); PG8_STAGE(PG8_SA(0, 0), a2, voffA);
            PG8_WAIT_V(8); PG8_WAIT_L(0); PG8_BAR; __builtin_amdgcn_s_setprio(1); PG8_MMAQ(1, 0, At, B0); PG8_MMAQ(1, 1, At, B1); __builtin_amdgcn_s_setprio(0); PG8_BAR; PG8_SCHED;
            PG8_LDB(B0, 1, 0); PG8_LDB(B1, 1, 1); PG8_SCHED; PG8_LDA(At, 1, 0); PG8_STAGE(PG8_SA(0, 1), a2 + hstep, voffA);
            PG8_WAIT_V(8); PG8_WAIT_L(0); PG8_BAR; __builtin_amdgcn_s_setprio(1); PG8_MMAQ(0, 0, At, B0); PG8_MMAQ(0, 1, At, B1); __builtin_amdgcn_s_setprio(0); PG8_BAR; PG8_SCHED;
            PG8_LDA(At, 1, 1); PG8_STAGE(PG8_SB(1, 0), b3, voffB); PG8_STAGE(PG8_SB(1, 1), b3 + hstep, voffB); PG8_STAGE(PG8_SA(1, 0), a3, voffA);
            PG8_WAIT_V(8); PG8_WAIT_L(0); PG8_BAR; __builtin_amdgcn_s_setprio(1); PG8_MMAQ(1, 0, At, B0); PG8_MMAQ(1, 1, At, B1); __builtin_amdgcn_s_setprio(0); PG8_BAR; PG8_SCHED;
            } else {
            PG8_LDB(B0, 0, 0); PG8_SCHED; PG8_LDA(At, 0, 0); PG8_STAGE(PG8_SA(1, 1), a1 + hstep, voffA);
            PG8_WAIT_L(8); PG8_BAR; PG8_WAIT_L(0); PG8_MMA(0, 0, At, B0); PG8_BAR; PG8_SCHED;
            PG8_LDB(B1, 0, 1); PG8_STAGE(PG8_SB(0, 0), b2, voffB);
            PG8_BAR; PG8_WAIT_L(0); PG8_MMA(0, 1, At, B1); PG8_BAR;
            PG8_LDA(At, 0, 1); PG8_STAGE(PG8_SA(0, 0), a2, voffA);
            PG8_BAR; PG8_WAIT_L(0); PG8_MMA(1, 0, At, B0); PG8_BAR; PG8_SCHED;
            PG8_STAGE(PG8_SB(0, 1), b2 + hstep, voffB);
            PG8_WAIT_V(6); PG8_BAR; PG8_MMA(1, 1, At, B1); PG8_BAR;
            PG8_LDB(B0, 1, 0); PG8_SCHED; PG8_LDA(At, 1, 0); PG8_STAGE(PG8_SA(0, 1), a2 + hstep, voffA);
            PG8_WAIT_L(8); PG8_BAR; PG8_WAIT_L(0); PG8_MMA(0, 0, At, B0); PG8_BAR; PG8_SCHED;
            PG8_LDB(B1, 1, 1); PG8_STAGE(PG8_SB(1, 0), b3, voffB);
            PG8_BAR; PG8_WAIT_L(0); PG8_MMA(0, 1, At, B1); PG8_BAR;
            PG8_LDA(At, 1, 1); PG8_STAGE(PG8_SA(1, 0), a3, voffA);
            PG8_BAR; PG8_WAIT_L(0); PG8_MMA(1, 0, At, B0); PG8_BAR; PG8_SCHED;
            PG8_STAGE(PG8_SB(1, 1), b3 + hstep, voffB);
            PG8_WAIT_V(6); PG8_BAR; PG8_MMA(1, 1, At, B1); PG8_BAR;
            }
        }
        if constexpr (ALIGN_EPI) { if (wr == 0) PG8_BAR; }
        if constexpr (!Epi::AFTER_DRAIN) { E(acc, cur, wr, wc, fr, fq); S.done(cur); }
        if (!has_next) break;
#pragma unroll
        for (int a = 0; a < 2; ++a)
#pragma unroll
            for (int b = 0; b < 2; ++b)
#pragma unroll
                for (int m = 0; m < 4; ++m)
#pragma unroll
                    for (int n = 0; n < 2; ++n) acc[a][b][m][n] = (f32x4){0.f, 0.f, 0.f, 0.f};
        cur = nxt; cA = nA; cB = nB; ++ui;
        if constexpr (ALIGN_EPI) { if (wr == 1) PG8_BAR; }
    }
    PG8_WAIT_V(0);
    if constexpr (!ALIGN_EPI) { if (wr == 0) PG8_BAR; }
    PG8_BAR;
    if constexpr (Epi::AFTER_DRAIN) { E.fused(acc, cur, wr, wc, fr, fq, lds, wid, lane); S.done(cur); }
#undef PG8_SA
#undef PG8_SB
#undef PG8_STAGE
#undef PG8_LDA
#undef PG8_LDB
#undef PG8_MMA
#undef PG8_MMAQ
#undef PG8_WAIT_V
#undef PG8_WAIT_L
#undef PG8_BAR
#undef PG8_SCHED
}
}

#include <hip/hip_cooperative_groups.h>
#include <cstdio>
#include <cstdint>
namespace cg = cooperative_groups;
using pg8::bf16_t; using pg8::bf16x8; using pg8::f32x4; using pg8::u32x4; using pg8::cvt_pk_bf16;
typedef unsigned u32;
typedef u32 u32x2 __attribute__((ext_vector_type(2)));
typedef float f32x16 __attribute__((ext_vector_type(16)));
typedef float f32x2_t __attribute__((ext_vector_type(2)));

#ifndef MK_MULTI
#define MK_MULTI 0
#endif
#define LAS __attribute__((address_space(3)))
#define XB_TMO      128
#define XB_XCNT(j)  (256  + 64 * (j))
#define XB_XSUB(j)  (1280 + 64 * (j))
#define XB_XGEN(j)  (2304 + 64 * (j))
#define XB_TOP      3328
#define XB_TOPGEN   3392
#define XCD_BAR_WORDS 3456
#define XB_SPIN_CAP (1u << 18)

__device__ __forceinline__ unsigned xb_ld(unsigned* p)              { return __hip_atomic_load(p, __ATOMIC_RELAXED, __HIP_MEMORY_SCOPE_AGENT); }
__device__ __forceinline__ unsigned xb_add(unsigned* p, unsigned v) { return __hip_atomic_fetch_add(p, v, __ATOMIC_RELAXED, __HIP_MEMORY_SCOPE_AGENT); }
__device__ __forceinline__ unsigned xb_xcc_id() { return (unsigned)__builtin_amdgcn_s_getreg((3 << 11) | 20) & 0xFu; }
#define XB_SPIN(cond, bar) do { unsigned _sp = 0; while (cond) { __builtin_amdgcn_s_sleep(1); \
    if ((++_sp & 255u) == 0u) { if (xb_ld(&(bar)[XB_TMO])) break; if (_sp > XB_SPIN_CAP) { atomicAdd(&(bar)[XB_TMO], 1u); break; } } } } while (0)

struct XcdBarrier {
    unsigned* bar; unsigned x; unsigned G;
    volatile LAS unsigned* st;
};

__device__ __forceinline__ XcdBarrier xcd_barrier_post(unsigned* bar, volatile LAS unsigned* st, unsigned G) {
    XcdBarrier b; b.bar = bar; b.x = xb_xcc_id(); b.st = st; b.G = G;
    if (threadIdx.x == 0) (void)xb_add(&bar[XB_XCNT(b.x)], 1u);
    return b;
}
__device__ __forceinline__ void xcd_barrier_complete(unsigned* bar, unsigned x, const unsigned G, unsigned& nloc, unsigned& nx) {
    unsigned sum, cnt, mine, sp = 0u;
    for (;;) {
        sum = 0u; cnt = 0u; mine = 0u;
#pragma unroll
        for (unsigned j = 0; j < 16; ++j) { const unsigned c = xb_ld(&bar[XB_XCNT(j)]); sum += c; cnt += (c > 0u) ? 1u : 0u; mine = (j == x) ? c : mine; }
        if (sum == G) break;
        __builtin_amdgcn_s_sleep(1);
        if ((++sp & 255u) == 0u) { if (xb_ld(&bar[XB_TMO])) break; if (sp > XB_SPIN_CAP) { atomicAdd(&bar[XB_TMO], 1u); break; } }
    }
    nloc = mine > 0u ? mine : 1u; nx = cnt > 0u ? cnt : 1u;
}

__device__ __forceinline__ void xcd_barrier(const XcdBarrier& b) {
    asm volatile("s_waitcnt vmcnt(0)" ::: "memory");
    __syncthreads();
    if (threadIdx.x == 0) {
        unsigned* bar = b.bar;
        __builtin_amdgcn_s_waitcnt(0);
        unsigned nloc = b.st[0], nx = b.st[1];
        if (nloc == 0u) { xcd_barrier_complete(bar, b.x, b.G, nloc, nx); b.st[0] = nloc; b.st[1] = nx; }
        const unsigned old = xb_add(&bar[XB_XSUB(b.x)], 1u);
        const unsigned gen = old / nloc;
        if (old + 1u == (gen + 1u) * nloc) {
            __builtin_amdgcn_fence(__ATOMIC_RELEASE, "agent");
            asm volatile("s_waitcnt vmcnt(0)" ::: "memory");
            const unsigned og = xb_add(&bar[XB_TOP], 1u);
            const unsigned tg = og / nx;
            if (og + 1u == (tg + 1u) * nx) xb_add(&bar[XB_TOPGEN], 1u);
            else XB_SPIN(xb_ld(&bar[XB_TOPGEN]) == tg, bar);
            __builtin_amdgcn_fence(__ATOMIC_ACQUIRE, "agent");
            xb_add(&bar[XB_XGEN(b.x)], 1u);
            asm volatile("s_waitcnt vmcnt(0)" ::: "memory");
        } else {
            XB_SPIN(xb_ld(&bar[XB_XGEN(b.x)]) == gen, bar);
            __builtin_amdgcn_fence(__ATOMIC_ACQUIRE, "agent");
            asm volatile("s_waitcnt vmcnt(0)" ::: "memory");
        }
    }
    __syncthreads();
}


constexpr int M_TOK = 65536, DM = 1024, SEQ = 8192;
constexpr int N_PHASES = 10;
constexpr int LDS_BYTES = 147456;
constexpr float RMS_EPS = 1e-6f;

constexpr size_t MiB = 1024ull * 1024ull;
constexpr size_t WS_WIN = 0, WS_WGLU = 4 * MiB, WS_WOUT = 5 * MiB, WS_WUP = 8 * MiB, WS_WDN = 16 * MiB;
constexpr size_t WS_TWST = 24 * MiB, WS_TWOUT = 26 * MiB, WS_TKT = 28 * MiB, WS_TSC = 29 * MiB, WS_BAR = 30 * MiB;
constexpr size_t WS_SS = 31 * MiB;
constexpr size_t WS_RINV = 31 * MiB + 512 * 1024;
constexpr size_t BAR_STRIDE = 16384, BAR_BYTES = 3 * BAR_STRIDE;
constexpr int LDS_ST_OFF = 147440;
constexpr size_t WS_GROUP0 = 32 * MiB, GROUP_BYTES = 464 * MiB;
constexpr size_t G_X1B = 0  , G_SWS = 0, G_CWS = 32 * MiB, G_U3 = 48 * MiB, G_HN = 80 * MiB, G_O = 144 * MiB, G_BIG = 208 * MiB;
constexpr size_t G_PROJ = G_BIG, G_YG = G_BIG + 96 * MiB, G_YGLU = G_BIG + 128 * MiB, G_YCAT = G_BIG + 160 * MiB, G_H = G_BIG;
constexpr size_t WS_END = WS_GROUP0 + 2 * GROUP_BYTES;
constexpr int KT_ELEMS = 17 * 256, KT_PLANE = 17 * 128;
constexpr int M_HALF = M_TOK / 2;

struct Ctx { int grp, vb, GV, m0; unsigned char* wsg; };

struct Args { const float* in[21]; float* out; unsigned char* ws; int ph_lo, ph_hi; };

__device__ __forceinline__ float bf_lo(u32 w) { return __uint_as_float(w << 16); }
__device__ __forceinline__ float bf_hi(u32 w) { return __uint_as_float(w & 0xffff0000u); }
__device__ __forceinline__ bf16_t f2bf(float f) { return (bf16_t)(cvt_pk_bf16(f, 0.f) & 0xffffu); }
__device__ __forceinline__ float wave_sum(float v) {
#pragma unroll
    for (int o = 1; o < 64; o <<= 1) v += __shfl_xor(v, o);
    return v;
}
__device__ __forceinline__ float fast_rcp(float x) { return __builtin_amdgcn_rcpf(x); }
__device__ __forceinline__ float sigmoidf_(float v) { return fast_rcp(1.f + __expf(-v)); }
__device__ __forceinline__ float gelu_tanh(float v) {
    const float t = v * (-2.3022082f + -0.10294324f * (v * v)); return v * fast_rcp(1.f + __builtin_amdgcn_exp2f(t)); }

struct EpiProj {
    static constexpr bool PERM = true, AFTER_DRAIN = false;
    bf16_t* U3; bf16_t* P;
    __device__ __forceinline__ void operator()(const f32x4 (&acc)[2][2][4][2], const pg8::Unit& u, int wr, int wc, int fr, int fq) const {
        const int row0 = u.pm * 256 + wr * 64 + fr, colb = u.pn * 256 + wc * 32 + 8 * fq;
#pragma unroll
        for (int ai = 0; ai < 2; ++ai)
#pragma unroll
            for (int m = 0; m < 4; ++m) {
                const int row = row0 + ai * 128 + m * 16;
                if (u.pn >= 2 && u.pn < 6) {
                    const f32x4 h0 = acc[ai][0][m][0], c0 = acc[ai][0][m][1], h1 = acc[ai][1][m][0], c1 = acc[ai][1][m][1];
                    u32x4 z; z.x = cvt_pk_bf16(h0[0] * c0[0], h0[1] * c0[1]); z.y = cvt_pk_bf16(h0[2] * c0[2], h0[3] * c0[3]); z.z = cvt_pk_bf16(h1[0] * c1[0], h1[1] * c1[1]); z.w = cvt_pk_bf16(h1[2] * c1[2], h1[3] * c1[3]);
                    *(u32x4*)(P + (size_t)row * 1024 + (u.pn - 2) * 128 + wc * 32 + 8 * fq) = z;
                } else {
#pragma unroll
                    for (int bj = 0; bj < 2; ++bj) {
                        const int col = colb + bj * 128;
                        const f32x4 v0 = acc[ai][bj][m][0], v1 = acc[ai][bj][m][1];
                        u32x4 w; w.x = cvt_pk_bf16(v0[0], v0[1]); w.y = cvt_pk_bf16(v0[2], v0[3]); w.z = cvt_pk_bf16(v1[0], v1[1]); w.w = cvt_pk_bf16(v1[2], v1[3]);
                        if (u.pn < 2) {
                            const int b = row >> 13, tl = row & 8191, g = col >> 4, hf = (col >> 3) & 1;
                            const size_t off = (((size_t)(b * 32 + g) * 8192 + tl) * 2 + hf) * 8;
                            *(u32x4*)(U3 + off) = w;
                        } else {
                            *(u32x4*)(P + (size_t)row * 1024 + 512 + (col - 1536)) = w;
                        }
                    }
                }
            }
    }
};
template <int ACT  > struct EpiStore {
    static constexpr bool PERM = true, AFTER_DRAIN = false;
    bf16_t* O; int ldc;
    __device__ __forceinline__ void operator()(const f32x4 (&acc)[2][2][4][2], const pg8::Unit& u, int wr, int wc, int fr, int fq) const {
        const int row0 = u.pm * 256 + wr * 64 + fr, colb = u.pn * 256 + wc * 32 + 8 * fq;
#pragma unroll
        for (int ai = 0; ai < 2; ++ai)
#pragma unroll
            for (int m = 0; m < 4; ++m) {
                bf16_t* rowp = O + (size_t)(row0 + ai * 128 + m * 16) * ldc + colb;
#pragma unroll
                for (int bj = 0; bj < 2; ++bj) {
                    f32x4 v0 = acc[ai][bj][m][0], v1 = acc[ai][bj][m][1];
                    if (ACT == 1) {
#pragma unroll
                        for (int j = 0; j < 4; ++j) {
                            float a0, a1; asm("v_max_f32 %0, 0, %1" : "=v"(a0) : "v"(v0[j])); asm("v_max_f32 %0, 0, %1" : "=v"(a1) : "v"(v1[j]));
                            f32x2_t p = (f32x2_t){a0, a1}; p = p * p; v0[j] = p.x; v1[j] = p.y; }
                    }
                    u32x4 w; w.x = cvt_pk_bf16(v0[0], v0[1]); w.y = cvt_pk_bf16(v0[2], v0[3]); w.z = cvt_pk_bf16(v1[0], v1[1]); w.w = cvt_pk_bf16(v1[2], v1[3]);
                    *(u32x4*)(rowp + bj * 128) = w;
                }
            }
    }
};
template <int ACT  > struct EpiStoreBlk {
    static constexpr bool PERM = true, AFTER_DRAIN = false;
    bf16_t* O; int ldc;
    __device__ __forceinline__ void operator()(const f32x4 (&acc)[2][2][4][2], const pg8::Unit& u, int wr, int wc, int fr, int fq) const {
        const int rb0 = u.pm * 16 + wr * 4, cb0 = u.pn * 8 + wc, cbs = ldc >> 5;
#pragma unroll
        for (int ai = 0; ai < 2; ++ai)
#pragma unroll
            for (int m = 0; m < 4; ++m) {
#pragma unroll
                for (int bj = 0; bj < 2; ++bj) {
                    f32x4 v0 = acc[ai][bj][m][0], v1 = acc[ai][bj][m][1];
                    if (ACT == 1) {
#pragma unroll
                        for (int j = 0; j < 4; ++j) {
                            float a0, a1; asm("v_max_f32 %0, 0, %1" : "=v"(a0) : "v"(v0[j])); asm("v_max_f32 %0, 0, %1" : "=v"(a1) : "v"(v1[j]));
                            f32x2_t p = (f32x2_t){a0, a1}; p = p * p; v0[j] = p.x; v1[j] = p.y; }
                    }
                    u32x4 w; w.x = cvt_pk_bf16(v0[0], v0[1]); w.y = cvt_pk_bf16(v0[2], v0[3]); w.z = cvt_pk_bf16(v1[0], v1[1]); w.w = cvt_pk_bf16(v1[2], v1[3]);
                    const size_t off = (((size_t)(rb0 + ai * 8 + m) * cbs + (cb0 + bj * 4)) * 16 + fr) * 32 + 8 * fq;
                    *(u32x4*)(O + off) = w;
                }
            }
    }
};
struct EpiGlu {
    static constexpr bool PERM = true, AFTER_DRAIN = false;
    const bf16_t* Y; bf16_t* O; const float* gs; float* SS;
    __device__ __forceinline__ void operator()(const f32x4 (&acc)[2][2][4][2], const pg8::Unit& u, int wr, int wc, int fr, int fq) const {
        const int row0 = u.pm * 256 + wr * 64 + fr, colb = u.pn * 256 + wc * 32 + 8 * fq;
        f32x4 g[2][2];
#pragma unroll
        for (int bj = 0; bj < 2; ++bj) { g[bj][0] = *(const f32x4*)(gs + colb + bj * 128); g[bj][1] = *(const f32x4*)(gs + colb + bj * 128 + 4); }
#pragma unroll
        for (int ai = 0; ai < 2; ++ai)
#pragma unroll
            for (int m = 0; m < 4; ++m) {
                const int row = row0 + ai * 128 + m * 16;
                float ss = 0.f;
#pragma unroll
                for (int bj = 0; bj < 2; ++bj) {
                    const f32x4 v0 = acc[ai][bj][m][0], v1 = acc[ai][bj][m][1];
                    const u32x4 y = *(const u32x4*)(Y + (size_t)row * 512 + colb + bj * 128);
                    f32x4 t0, t1;
                    t0[0] = bf_lo(y.x) * sigmoidf_(v0[0]); t0[1] = bf_hi(y.x) * sigmoidf_(v0[1]); t0[2] = bf_lo(y.y) * sigmoidf_(v0[2]); t0[3] = bf_hi(y.y) * sigmoidf_(v0[3]);
                    t1[0] = bf_lo(y.z) * sigmoidf_(v1[0]); t1[1] = bf_hi(y.z) * sigmoidf_(v1[1]); t1[2] = bf_lo(y.w) * sigmoidf_(v1[2]); t1[3] = bf_hi(y.w) * sigmoidf_(v1[3]);
                    ss += (t0[0] * t0[0] + t0[1] * t0[1]) + (t0[2] * t0[2] + t0[3] * t0[3]) + (t1[0] * t1[0] + t1[1] * t1[1]) + (t1[2] * t1[2] + t1[3] * t1[3]);
                    t0 = t0 * g[bj][0]; t1 = t1 * g[bj][1];
                    u32x4 w; w.x = cvt_pk_bf16(t0[0], t0[1]); w.y = cvt_pk_bf16(t0[2], t0[3]); w.z = cvt_pk_bf16(t1[0], t1[1]); w.w = cvt_pk_bf16(t1[2], t1[3]);
                    *(u32x4*)(O + (size_t)row * 1024 + colb + bj * 128) = w;
                }
                ss += __shfl_xor(ss, 16); ss += __shfl_xor(ss, 32);
                if (fq == 0) unsafeAtomicAdd(SS + row, ss);
            }
    }
};

__device__ __forceinline__ void cpowd(double lrdt, double lidt, double k, float& re, float& im) {
    const double mag = exp(lrdt * k);
    double ang = lidt * k;
    ang -= 6.283185307179586476925 * rint(ang * 0.15915494309189533577);
    re = (float)(mag * cos(ang)); im = (float)(mag * sin(ang));
}
__device__ __forceinline__ void transpose_item(const float* W, int K, int N, bf16_t* WT, float* scr, int item, int lane, const float* gk = nullptr, bool win_map = false) {
    const int nblk = N / 32, kb = item / nblk, nb = item % nblk, k0 = 64 * kb, n0 = 32 * nb;
#pragma unroll 8
    for (int i = 0; i < 32; ++i) { const int kk = 2 * i + (lane >> 5); float w = W[(size_t)(k0 + kk) * N + n0 + (lane & 31)]; if (gk) w *= gk[k0 + kk]; scr[kk * 33 + (lane & 31)] = w; }
    __builtin_amdgcn_s_waitcnt(0xc07f); asm volatile("" ::: "memory");
    const int c = lane & 7;
#pragma unroll
    for (int j = 0; j < 4; ++j) { const int n = (lane >> 3) + 8 * j; const float* s = scr + (8 * c) * 33 + n;
        u32x4 o; o.x = cvt_pk_bf16(s[0 * 33], s[1 * 33]); o.y = cvt_pk_bf16(s[2 * 33], s[3 * 33]); o.z = cvt_pk_bf16(s[4 * 33], s[5 * 33]); o.w = cvt_pk_bf16(s[6 * 33], s[7 * 33]);
        int nr = n0 + n;
        if (win_map && nr >= 512) {
            if (nr < 1024 || nr >= 1536) { const int nn = nr >= 1536, ch = nr - (nn ? 1536 : 512), r = ch & 127;
                nr = 512 + 256 * (ch >> 7) + 128 * ((r >> 2) & 1) + 32 * (r >> 5) + 8 * ((r >> 3) & 3) + 4 * nn + (r & 3); }
            else nr = nr + 512;
        }
        *(u32x4*)(WT + (size_t)nr * K + k0 + 8 * c) = o; }
    __builtin_amdgcn_s_waitcnt(0xc07f); asm volatile("" ::: "memory");
}
__device__ __forceinline__ void phase_prep_w(const Args& a, const Ctx& c, unsigned char* lds) {
    const int tid = threadIdx.x, lane = tid & 63, wave = tid >> 6;
    const int gw = c.vb * 8 + wave, NGW = c.GV * 8;
    unsigned char* ws = a.ws;
    {
        const float* lam_re = a.in[3]; const float* lam_im = a.in[4]; const float* log_dt = a.in[5];
        const float* b_re = a.in[6]; const float* b_im = a.in[7]; const float* c_re = a.in[8]; const float* c_im = a.in[9]; const float* d_skip = a.in[10];
        float2* shpow = (float2*)(lds + 69632);
        float2* shcoef = (float2*)(lds + 69632 + 6144);
        float2* shB = (float2*)(lds + 69632 + 8192);
        float2* shC = (float2*)(lds + 69632 + 16384);
        bf16_t* TWST = (bf16_t*)(ws + WS_TWST); bf16_t* TWOUT = (bf16_t*)(ws + WS_TWOUT); bf16_t* TKT = (bf16_t*)(ws + WS_TKT); float4* TSC = (float4*)(ws + WS_TSC);
        for (int it = c.vb; it < 128; it += c.GV) {
            const int g = it >> 2, jq = it & 3;
            if (tid < 256) {
                const int p = tid & 63, jj = tid >> 6, j = 4 * jq + jj;
                const double dt = exp((double)log_dt[g]);
                const double lr = (double)lam_re[g * 64 + p], li = (double)lam_im[g * 64 + p];
                const double lrdt = lr * dt, lidt = li * dt;
                float r0, i0, r1, i1, r2, i2;
                cpowd(lrdt, lidt, (double)j, r0, i0); cpowd(lrdt, lidt, (double)(15 - j), r1, i1); cpowd(lrdt, lidt, (double)(j + 1), r2, i2);
                shpow[(jj * 3 + 0) * 64 + p] = make_float2(r0, i0); shpow[(jj * 3 + 1) * 64 + p] = make_float2(r1, i1); shpow[(jj * 3 + 2) * 64 + p] = make_float2(r2, i2);
                if (jj == 0) {
                    const double mag = exp(lrdt); double ang = lidt; ang -= 6.283185307179586476925 * rint(ang * 0.15915494309189533577);
                    const double nr = mag * cos(ang) - 1.0, ni = mag * sin(ang), den = lr * lr + li * li;
                    shcoef[p] = make_float2((float)((nr * lr + ni * li) / den), (float)((ni * lr - nr * li) / den));
                    if (jq == 0) { float ar, ai, br, bi; cpowd(lrdt, lidt, 16.0, ar, ai); cpowd(lrdt, lidt, 1024.0, br, bi); TSC[g * 64 + p] = make_float4(ar, ai, br, bi); }
                }
            }
            __syncthreads();
#pragma unroll
            for (int i = 0; i < 2; ++i) {
                const int e = tid + 512 * i;
                { const int p = e >> 4; const float2 co = shcoef[p]; const float br = b_re[g * 1024 + e], bi = b_im[g * 1024 + e]; shB[e] = make_float2(co.x * br - co.y * bi, co.x * bi + co.y * br); }
                shC[e] = make_float2(c_re[g * 1024 + e], c_im[g * 1024 + e]);
            }
            __syncthreads();
#pragma unroll
            for (int i = 0; i < 2; ++i) {
                const int e = tid + 512 * i, jj = e >> 8, hp = (e >> 4) & 15, h = e & 15, j = 4 * jq + jj; float val = 0.f;
#pragma unroll 8
                for (int p = 0; p < 64; ++p) {
                    const float2 A = shpow[(jj * 3 + 0) * 64 + p], bb = shB[p * 16 + h], cc = shC[hp * 64 + p];
                    const float tr = A.x * bb.x - A.y * bb.y, ti = A.x * bb.y + A.y * bb.x;
                    val += cc.x * tr - cc.y * ti;
                }
                if (j == 0 && hp == h) val += d_skip[g * 16 + hp];
                TKT[(size_t)g * KT_ELEMS + (h >> 3) * KT_PLANE + (1 + j) * 128 + hp * 8 + (h & 7)] = f2bf(val);
                if (jq == 0 && e < 256) TKT[(size_t)g * KT_ELEMS + (e >> 7) * KT_PLANE + (e & 127)] = 0;
            }
#pragma unroll 1
            for (int jj = 0; jj < 4; ++jj) {
                const int j = 4 * jq + jj;
#pragma unroll
                for (int i = 0; i < 4; ++i) {
                    const int e = tid + 512 * i;
                    {
                        const int h = e & 15, col = e >> 4, cidx = col >> 6, p = col & 63;
                        const float2 A = shpow[(jj * 3 + 1) * 64 + p], bb = shB[p * 16 + h];
                        const float tr = A.x * bb.x - A.y * bb.y, ti = A.x * bb.y + A.y * bb.x;
                        TWST[(size_t)g * 32768 + j * 2048 + (col >> 5) * 512 + (h >> 3) * 256 + (col & 31) * 8 + (h & 7)] = f2bf(cidx ? ti : tr);
                    }
                    {
                        const int hp = e & 15, p = (e >> 4) & 63, cidx = e >> 10;
                        const float2 A = shpow[(jj * 3 + 2) * 64 + p], cc = shC[hp * 64 + p];
                        const float tr = cc.x * A.x - cc.y * A.y, ti = cc.x * A.y + cc.y * A.x;
                        const int ni = j >> 1, n = (j & 1) * 16 + hp, kk = cidx * 4 + (p >> 4), k = p & 15;
                        TWOUT[(size_t)g * 32768 + (kk * 8 + ni) * 512 + (k >> 3) * 256 + n * 8 + (k & 7)] = f2bf(cidx ? -ti : tr);
                    }
                }
            }
            __syncthreads();
        }
    }
    {
        float* scr = (float*)(lds + wave * 8448);
        constexpr int I_IN = 16 * 64, I_GLU = 8 * 16, I_OUT = 16 * 32, I_UP = 16 * 128, I_DN = 64 * 32;
        constexpr int NITEMS = I_IN + I_GLU + I_OUT + I_UP + I_DN;
        for (int it = gw; it < NITEMS; it += NGW) {
            int r = it;
            if (r < I_IN) { transpose_item(a.in[2], 1024, 2048, (bf16_t*)(ws + WS_WIN), scr, r, lane, nullptr, true); continue; } r -= I_IN;
            if (r < I_GLU) { transpose_item(a.in[11], 512, 512, (bf16_t*)(ws + WS_WGLU), scr, r, lane); continue; } r -= I_GLU;
            if (r < I_OUT) { transpose_item(a.in[15], 1024, 1024, (bf16_t*)(ws + WS_WOUT), scr, r, lane); continue; } r -= I_OUT;
            if (r < I_UP) { transpose_item(a.in[18], 1024, 4096, (bf16_t*)(ws + WS_WUP), scr, r, lane, a.in[17]); continue; } r -= I_UP;
            transpose_item(a.in[19], 4096, 1024, (bf16_t*)(ws + WS_WDN), scr, r, lane);
        }
    }
}
__device__ __forceinline__ float pair_sum(float v) {
    v += __shfl_xor(v, 1); v += __shfl_xor(v, 2); v += __shfl_xor(v, 4); v += __shfl_xor(v, 16); v += __shfl_xor(v, 32); return v;
}
__device__ __forceinline__ void phase_xnorm(const Args& a, const Ctx& c) {
    const int tid = threadIdx.x, lane = tid & 63, wave = tid >> 6;
    const int gw = c.vb * 8 + wave, NGW = c.GV * 8;
    { float* SS = (float*)(a.ws + WS_SS) + (size_t)c.grp * M_HALF; for (int i = c.vb * 512 + tid; i < M_HALF; i += c.GV * 512) SS[i] = 0.f; }
    const float* x = a.in[0] + (size_t)c.m0 * DM; const float* gp = a.in[1]; bf16_t* HN = (bf16_t*)(c.wsg + G_HN); float* RINV = (float*)(a.ws + WS_RINV) + (size_t)c.grp * M_HALF;
    const int sub = (lane >> 3) & 1, cl = 32 * (lane >> 4) + 4 * (lane & 7);
    f32x4 gv[8];
#pragma unroll
    for (int j = 0; j < 8; ++j) gv[j] = *(const f32x4*)(gp + cl + 128 * j);
    f32x4 v[8], nx[8];
#pragma unroll
    for (int j = 0; j < 8; ++j) v[j] = __builtin_nontemporal_load((const f32x4*)(x + (size_t)(2 * gw + sub) * DM + cl + 128 * j));
    for (int pr = gw; pr < M_HALF / 2; pr += NGW) {
        const int pn = pr + NGW, r = 2 * pr;
        if (pn < M_HALF / 2) {
#pragma unroll
            for (int j = 0; j < 8; ++j) nx[j] = __builtin_nontemporal_load((const f32x4*)(x + (size_t)(2 * pn + sub) * DM + cl + 128 * j));
        }
        float ss = 0.f;
#pragma unroll
        for (int j = 0; j < 8; ++j) ss += (v[j].x * v[j].x + v[j].y * v[j].y) + (v[j].z * v[j].z + v[j].w * v[j].w);
        const float q = pair_sum(ss) * (1.f / DM) + RMS_EPS, rr = rsqrtf(q);
        if ((lane & 0x37) == 0) RINV[r + sub] = q * rr;
        bf16_t* hb = HN + (size_t)(r >> 4) * 16384 + (r & 15) * 32 + (lane >> 4) * 512 + (lane & 15) * 4;
#pragma unroll
        for (int j = 0; j < 8; ++j) {
            u32x2 o; o.x = cvt_pk_bf16(v[j].x * rr * gv[j].x, v[j].y * rr * gv[j].y); o.y = cvt_pk_bf16(v[j].z * rr * gv[j].z, v[j].w * rr * gv[j].w);
            *(u32x2*)(hb + j * 2048) = o;
        }
#pragma unroll
        for (int j = 0; j < 8; ++j) v[j] = nx[j];
    }
}

__device__ __forceinline__ f32x16 mfma32(bf16x8 a, bf16x8 b, f32x16 c) { return __builtin_amdgcn_mfma_f32_32x32x16_bf16(a, b, c, 0, 0, 0); }
__device__ __forceinline__ void phase_ssm(const Args& a, const Ctx& c, unsigned char* ldsg) {
    const int tid = threadIdx.x, lane = tid & 63, wave = __builtin_amdgcn_readfirstlane(tid >> 6);
    unsigned char* ws = a.ws;
    const bf16_t* lw = (const bf16_t*)ldsg;
    float2* shE = (float2*)(ldsg + 139776);
    const bf16_t* U3 = (const bf16_t*)(c.wsg + G_U3);
    bf16_t* YG = (bf16_t*)(c.wsg + G_YG);
    const float4* TSC = (const float4*)(ws + WS_TSC);
    const int boff = (lane >> 5) * 256 + (lane & 31) * 8;
    const int koff = (lane >> 5) * KT_PLANE + (lane & 31) * 8;
    for (int item = c.vb; item < 128; item += c.GV) {
        const int b = item >> 5, g = item & 31;
        {
            const u32x4* s0 = (const u32x4*)(ws + WS_TWST + (size_t)g * 65536); u32x4* d0 = (u32x4*)ldsg;
            const u32x4* s1 = (const u32x4*)(ws + WS_TWOUT + (size_t)g * 65536); u32x4* d1 = (u32x4*)(ldsg + 65536);
            const u32x4* s2 = (const u32x4*)(ws + WS_TKT + (size_t)g * (KT_ELEMS * 2)); u32x4* d2 = (u32x4*)(ldsg + 131072);
#pragma unroll
            for (int i = 0; i < 8; ++i) { d0[tid + 512 * i] = s0[tid + 512 * i]; d1[tid + 512 * i] = s1[tid + 512 * i]; }
            for (int i = tid; i < (KT_ELEMS * 2) / 16; i += 512) d2[i] = s2[i];
        }
        __syncthreads();
        const bf16_t* Ubg = U3 + (size_t)item * 131072;
        const bf16_t* Ul = Ubg + (lane & 31) * 256 + (lane >> 5) * 8;
        float* Sw = (float*)(c.wsg + G_SWS) + (size_t)item * 65536;
        bf16_t* Cw = (bf16_t*)(c.wsg + G_CWS) + (size_t)item * 65536;
        for (int q = 0; q < 2; ++q) {
            const int mb = wave * 2 + q;
            bf16x8 ua[16];
#pragma unroll
            for (int s = 0; s < 16; ++s) ua[s] = *(const bf16x8*)(Ul + mb * 8192 + s * 16);
#pragma unroll 1
            for (int nb = 0; nb < 4; ++nb) {
                f32x16 acc;
#pragma unroll
                for (int r = 0; r < 16; ++r) acc[r] = 0.f;
#pragma unroll
                for (int s = 0; s < 16; ++s) { const bf16x8 B = *(const bf16x8*)(lw + (s * 4 + nb) * 512 + boff); acc = mfma32(ua[s], B, acc); }
#pragma unroll
                for (int r = 0; r < 16; ++r) { const int row = (r & 3) + 8 * (r >> 2) + 4 * (lane >> 5); Sw[(size_t)(mb * 32 + row) * 128 + nb * 32 + (lane & 31)] = acc[r]; }
            }
        }
        __builtin_amdgcn_fence(__ATOMIC_RELEASE, "workgroup"); asm volatile("s_waitcnt vmcnt(0)" ::: "memory"); __builtin_amdgcn_fence(__ATOMIC_ACQUIRE, "workgroup");
        {
            const float4 sc = TSC[g * 64 + lane];
            const float* Sp = Sw + (size_t)(wave * 64) * 128 + lane;
            float sr[32], si[32];
            float xr = 0.f, xi = 0.f;
#pragma unroll 1
            for (int hb = 0; hb < 2; ++hb) {
#pragma unroll
                for (int n = 0; n < 32; ++n) { sr[n] = Sp[(hb * 32 + n) * 128]; si[n] = Sp[(hb * 32 + n) * 128 + 64]; }
#pragma unroll
                for (int n = 0; n < 32; ++n) { const float nr = sc.x * xr - sc.y * xi + sr[n], ni = sc.x * xi + sc.y * xr + si[n]; xr = nr; xi = ni; }
            }
            shE[wave * 64 + lane] = make_float2(xr, xi);
            __syncthreads();
            xr = 0.f; xi = 0.f;
            for (int v = 0; v < wave; ++v) { const float2 e = shE[v * 64 + lane]; const float nr = sc.z * xr - sc.w * xi + e.x, ni = sc.z * xi + sc.w * xr + e.y; xr = nr; xi = ni; }
            bf16_t* Cp = Cw + (size_t)(wave * 64) * 128 + lane;
#pragma unroll 1
            for (int hb = 0; hb < 2; ++hb) {
#pragma unroll
                for (int n = 0; n < 32; ++n) { sr[n] = Sp[(hb * 32 + n) * 128]; si[n] = Sp[(hb * 32 + n) * 128 + 64]; }
#pragma unroll
                for (int n = 0; n < 32; ++n) {
                    Cp[(hb * 32 + n) * 128] = f2bf(xr); Cp[(hb * 32 + n) * 128 + 64] = f2bf(xi);
                    const float nr = sc.x * xr - sc.y * xi + sr[n], ni = sc.x * xi + sc.y * xr + si[n]; xr = nr; xi = ni;
                }
            }
        }
        __builtin_amdgcn_fence(__ATOMIC_RELEASE, "workgroup"); asm volatile("s_waitcnt vmcnt(0)" ::: "memory"); __builtin_amdgcn_fence(__ATOMIC_ACQUIRE, "workgroup");
        for (int q = 0; q < 2; ++q) {
            const int mb = wave * 2 + q;
            bf16x8 ua[16], ca[8];
#pragma unroll
            for (int s = 0; s < 16; ++s) ua[s] = *(const bf16x8*)(Ul + mb * 8192 + s * 16);
#pragma unroll
            for (int kk = 0; kk < 8; ++kk) ca[kk] = *(const bf16x8*)(Cw + (size_t)(mb * 32 + (lane & 31)) * 128 + kk * 16 + (lane >> 5) * 8);
#pragma unroll 1
            for (int ni = 0; ni < 8; ++ni) {
                f32x16 acc;
#pragma unroll
                for (int r = 0; r < 16; ++r) acc[r] = 0.f;
#pragma unroll
                for (int s = 0; s < 16; ++s) if (s <= 2 * ni + 1) { const bf16x8 B = *(const bf16x8*)(lw + 65536 + (2 * ni - s + 1) * 128 + koff); acc = mfma32(ua[s], B, acc); }
#pragma unroll
                for (int kk = 0; kk < 8; ++kk) { const bf16x8 B = *(const bf16x8*)(lw + 32768 + (kk * 8 + ni) * 512 + boff); acc = mfma32(ca[kk], B, acc); }
                const int tau = 2 * ni + ((lane & 31) >> 4), hp = lane & 15;
#pragma unroll
                for (int r = 0; r < 16; ++r) {
                    const int row = (r & 3) + 8 * (r >> 2) + 4 * (lane >> 5);
                    const int tl = (mb * 32 + row) * 16 + tau;
                    YG[((size_t)(b * SEQ + tl)) * 512 + g * 16 + hp] = f2bf(gelu_tanh(acc[r]));
                }
            }
        }
        __syncthreads();
    }
}

__device__ __forceinline__ void unpack8(const u32x4 w, float (&f)[8]) { f[0] = bf_lo(w.x); f[1] = bf_hi(w.x); f[2] = bf_lo(w.y); f[3] = bf_hi(w.y); f[4] = bf_lo(w.z); f[5] = bf_hi(w.z); f[6] = bf_lo(w.w); f[7] = bf_hi(w.w); }
__device__ __forceinline__ u32x4 pack8(const float (&f)[8]) { u32x4 w; w.x = cvt_pk_bf16(f[0], f[1]); w.y = cvt_pk_bf16(f[2], f[3]); w.z = cvt_pk_bf16(f[4], f[5]); w.w = cvt_pk_bf16(f[6], f[7]); return w; }
__device__ __forceinline__ void phase_mix(const Args& a, const Ctx& c) {
    const int tid = threadIdx.x, lane = tid & 63, wave = tid >> 6;
    const int gw = c.vb * 8 + wave, NGW = c.GV * 8;
    const bf16_t* P = (const bf16_t*)(c.wsg + G_PROJ); bf16_t* YCAT = (bf16_t*)(c.wsg + G_YCAT); const float* SS = (const float*)(a.ws + WS_SS) + (size_t)c.grp * M_HALF;
    const float* cw = a.in[12]; const float* gc = a.in[14];
    const int j0 = 8 * lane;
    float w0[8], w1[8], w2[8], gcv[8];
#pragma unroll
    for (int j = 0; j < 8; ++j) { w0[j] = cw[j0 + j]; w1[j] = cw[512 + j0 + j]; w2[j] = cw[1024 + j0 + j]; gcv[j] = gc[j0 + j]; }
    constexpr int STRIP = 32;
    for (int st = gw; st < M_HALF / STRIP; st += NGW) {
        const int row0 = st * STRIP;
        float zp2[8], zp1[8];
        if ((row0 & (SEQ - 1)) == 0) {
#pragma unroll
            for (int j = 0; j < 8; ++j) { zp2[j] = 0.f; zp1[j] = 0.f; }
        } else {
            unpack8(*(const u32x4*)(P + (size_t)(row0 - 2) * 1024 + j0), zp2);
            unpack8(*(const u32x4*)(P + (size_t)(row0 - 1) * 1024 + j0), zp1);
        }
        constexpr int PR = 4;
        u32x4 lz[PR], lb[PR], nz[PR], nb[PR]; float ly[PR], ny[PR];
#pragma unroll
        for (int k = 0; k < PR; ++k) { const size_t r = (size_t)(row0 + k); lz[k] = *(const u32x4*)(P + r * 1024 + j0); lb[k] = *(const u32x4*)(P + r * 1024 + 512 + j0); ly[k] = SS[r]; }
        for (int i = 0; i < STRIP; i += PR) {
            if (i + PR < STRIP) {
#pragma unroll
                for (int k = 0; k < PR; ++k) { const size_t r = (size_t)(row0 + i + PR + k); nz[k] = *(const u32x4*)(P + r * 1024 + j0); nb[k] = *(const u32x4*)(P + r * 1024 + 512 + j0); ny[k] = SS[r]; }
            }
#pragma unroll
            for (int k = 0; k < PR; ++k) {
                const int row = row0 + i + k;
                float bg[8], z[8], yc[8];
                unpack8(lz[k], z); unpack8(lb[k], bg);
                float ssc = 0.f;
#pragma unroll
                for (int j = 0; j < 8; ++j) { yc[j] = bg[j] * (w0[j] * zp2[j] + w1[j] * zp1[j] + w2[j] * z[j]); ssc += yc[j] * yc[j]; }
                ssc = wave_sum(ssc);
                const float rc = rsqrtf(ssc * (1.f / 512.f) + RMS_EPS) * sqrtf(ly[k] * (1.f / 512.f) + RMS_EPS);
#pragma unroll
                for (int j = 0; j < 8; ++j) { yc[j] = yc[j] * rc * gcv[j]; zp2[j] = zp1[j]; zp1[j] = z[j]; }
                *(u32x4*)(YCAT + (size_t)row * 1024 + 512 + j0) = pack8(yc);
            }
#pragma unroll
            for (int k = 0; k < PR; ++k) { lz[k] = nz[k]; lb[k] = nb[k]; ly[k] = ny[k]; }
        }
    }
}

__device__ __forceinline__ void phase_resid6(const Args& a, const Ctx& c) {
    const int tid = threadIdx.x, lane = tid & 63, wave = tid >> 6;
    const int gw = c.vb * 8 + wave, NGW = c.GV * 8;
    const bf16_t* HN = (const bf16_t*)(c.wsg + G_HN); const float* RINV = (const float*)(a.ws + WS_RINV) + (size_t)c.grp * M_HALF;
    const bf16_t* O = (const bf16_t*)(c.wsg + G_O); bf16_t* X1B = (bf16_t*)(c.wsg + G_X1B);
    const float* SS = (const float*)(a.ws + WS_SS) + (size_t)c.grp * M_HALF;
    const int sub = (lane >> 3) & 1, cl = 32 * (lane >> 4) + 4 * (lane & 7), lo = (lane >> 4) * 512 + (lane & 15) * 4;
    f32x4 g1[8], gi[8];
#pragma unroll
    for (int j = 0; j < 8; ++j) { g1[j] = *(const f32x4*)(a.in[16] + cl + 128 * j); const f32x4 g0 = *(const f32x4*)(a.in[1] + cl + 128 * j); gi[j] = (f32x4){1.f / g0.x, 1.f / g0.y, 1.f / g0.z, 1.f / g0.w}; }
    u32x2 xv[8], nxv[8], ov[8], nov[8]; float ssv, nssv = 0.f, riv, nriv = 0.f;
    { const int r = 2 * gw; const size_t bo = (size_t)(r >> 4) * 16384 + (r & 15) * 32 + lo; ssv = SS[r + sub]; riv = RINV[r + sub];
#pragma unroll
      for (int j = 0; j < 8; ++j) { xv[j] = *(const u32x2*)(HN + bo + j * 2048); ov[j] = *(const u32x2*)(O + bo + j * 2048); } }
    for (int pr = gw; pr < M_HALF / 2; pr += NGW) {
        const int pn = pr + NGW, r = 2 * pr;
        if (pn < M_HALF / 2) { const int rn = 2 * pn; const size_t bo = (size_t)(rn >> 4) * 16384 + (rn & 15) * 32 + lo; nssv = SS[rn + sub]; nriv = RINV[rn + sub];
#pragma unroll
            for (int j = 0; j < 8; ++j) { nxv[j] = *(const u32x2*)(HN + bo + j * 2048); nov[j] = *(const u32x2*)(O + bo + j * 2048); } }
        f32x4 of[8]; float so = 0.f;
#pragma unroll
        for (int j = 0; j < 8; ++j) { of[j] = (f32x4){bf_lo(ov[j].x), bf_hi(ov[j].x), bf_lo(ov[j].y), bf_hi(ov[j].y)}; so += (of[j].x * of[j].x + of[j].y * of[j].y) + (of[j].z * of[j].z + of[j].w * of[j].w); }
        const float ro = rsqrtf(pair_sum(so) * (1.f / DM) + RMS_EPS * (ssv * (1.f / 512.f) + RMS_EPS));
        bf16_t* xb = X1B + (size_t)(r >> 4) * 16384 + (r & 15) * 32 + lo;
#pragma unroll
        for (int j = 0; j < 8; ++j) {
            const f32x4 xr = (f32x4){bf_lo(xv[j].x), bf_hi(xv[j].x), bf_lo(xv[j].y), bf_hi(xv[j].y)} * gi[j] * riv;
            const f32x4 x1 = xr + of[j] * ro * g1[j];
            u32x2 q; q.x = cvt_pk_bf16(x1.x, x1.y); q.y = cvt_pk_bf16(x1.z, x1.w); *(u32x2*)(xb + j * 2048) = q;
        }
#pragma unroll
        for (int j = 0; j < 8; ++j) { xv[j] = nxv[j]; ov[j] = nov[j]; }
        ssv = nssv; riv = nriv;
    }
}
__device__ __forceinline__ void phase_final(const Args& a, const Ctx& c) {
    const int tid = threadIdx.x, lane = tid & 63, wave = tid >> 6;
    const int gw = c.vb * 8 + wave, NGW = c.GV * 8;
    float* outp = a.out + (size_t)c.m0 * DM;
    const bf16_t* MO = (const bf16_t*)(c.wsg + G_HN); const bf16_t* X1B = (const bf16_t*)(c.wsg + G_X1B);
    const int sub = (lane >> 3) & 1, cl = 32 * (lane >> 4) + 4 * (lane & 7), lo = (lane >> 4) * 512 + (lane & 15) * 4;
    f32x4 g2[8];
#pragma unroll
    for (int j = 0; j < 8; ++j) g2[j] = *(const f32x4*)(a.in[20] + cl + 128 * j);
    u32x2 xv[8], nxv[8], mv[8], nmv[8];
    { const int r = 2 * gw; const size_t bo = (size_t)(r >> 4) * 16384 + (r & 15) * 32 + lo;
#pragma unroll
      for (int j = 0; j < 8; ++j) { xv[j] = *(const u32x2*)(X1B + bo + j * 2048); mv[j] = *(const u32x2*)(MO + bo + j * 2048); } }
    for (int pr = gw; pr < M_HALF / 2; pr += NGW) {
        const int pn = pr + NGW, r = 2 * pr;
        if (pn < M_HALF / 2) { const int rn = 2 * pn; const size_t bo = (size_t)(rn >> 4) * 16384 + (rn & 15) * 32 + lo;
#pragma unroll
            for (int j = 0; j < 8; ++j) { nxv[j] = *(const u32x2*)(X1B + bo + j * 2048); nmv[j] = *(const u32x2*)(MO + bo + j * 2048); } }
        f32x4 mf[8], x1[8]; float sm = 0.f, s1 = 0.f;
#pragma unroll
        for (int j = 0; j < 8; ++j) { mf[j] = (f32x4){bf_lo(mv[j].x), bf_hi(mv[j].x), bf_lo(mv[j].y), bf_hi(mv[j].y)};
            x1[j] = (f32x4){bf_lo(xv[j].x), bf_hi(xv[j].x), bf_lo(xv[j].y), bf_hi(xv[j].y)};
            sm += (mf[j].x * mf[j].x + mf[j].y * mf[j].y) + (mf[j].z * mf[j].z + mf[j].w * mf[j].w);
            s1 += (x1[j].x * x1[j].x + x1[j].y * x1[j].y) + (x1[j].z * x1[j].z + x1[j].w * x1[j].w); }
        sm = pair_sum(sm); s1 = pair_sum(s1);
        const float q1 = s1 * (1.f / DM) + RMS_EPS;
        const float rm = rsqrtf(sm * (1.f / DM) + RMS_EPS * q1 * q1);
        float* ob = outp + (size_t)(r + sub) * DM + cl;
#pragma unroll
        for (int j = 0; j < 8; ++j) __builtin_nontemporal_store(x1[j] + mf[j] * rm * g2[j], (f32x4*)(ob + 128 * j));
#pragma unroll
        for (int j = 0; j < 8; ++j) { xv[j] = nxv[j]; mv[j] = nmv[j]; }
    }
}

template <class Epi, bool ABLK = false> __device__ __forceinline__ void run_gemm(unsigned char* lds, const Ctx& c, const bf16_t* A, const bf16_t* Bt, int N, int K, const Epi& E) {
    pg8::StaticOrder S; S.init(M_HALF, N, c.GV, c.vb, 4);
    pg8::gemm_phase<Epi, pg8::StaticOrder, true, true, ABLK>((PG8_LAS unsigned char*)lds, pg8::Gemm{A, Bt, M_HALF, N, K}, S, E);
}
#ifdef PROBE_DUMMY
struct ProbeOrder : pg8::StaticOrder {
    int mode;
    __device__ bool next(int i, pg8::Unit& u) const { if (mode) { if (i >= 16) return false; u.pm = 0; u.pn = 0; return true; } return pg8::StaticOrder::next(i, u); }
};
#endif
__global__ void __launch_bounds__(512, 2) hymba_fwd(Args a) {
    extern __shared__ __attribute__((aligned(16))) unsigned char lds[];
    Ctx c;
    c.GV = (int)gridDim.x >> 1; c.grp = ((int)blockIdx.x & 7) >> 2; c.vb = (((int)blockIdx.x >> 3) << 2) | ((int)blockIdx.x & 3);
    c.m0 = c.grp * M_HALF; c.wsg = a.ws + WS_GROUP0 + (size_t)c.grp * GROUP_BYTES;
    unsigned char* ws = a.ws; unsigned char* wsg = c.wsg;
    volatile LAS unsigned* st = (volatile LAS unsigned*)((LAS unsigned char*)lds + LDS_ST_OFF);
    if (threadIdx.x < 4) st[threadIdx.x] = 0u;
    __syncthreads();
    const XcdBarrier gb = xcd_barrier_post((unsigned*)(ws + WS_BAR + (size_t)c.grp * BAR_STRIDE), st, (unsigned)c.GV);
    unsigned* wready = (unsigned*)(ws + WS_BAR + 2 * BAR_STRIDE);
    if (a.ph_lo < 0) cg::this_grid().sync();
    if (c.grp == 1) {
        phase_prep_w(a, c, lds);
#if defined(PROBE_X2) && (PROBE_X2 & 1)
        __syncthreads(); phase_prep_w(a, c, lds);
#endif
        asm volatile("s_waitcnt vmcnt(0)" ::: "memory");
        __syncthreads();
        if (threadIdx.x == 0) {
            __builtin_amdgcn_fence(__ATOMIC_RELEASE, "agent");
            asm volatile("s_waitcnt vmcnt(0)" ::: "memory");
            (void)__hip_atomic_fetch_add(wready, 1u, __ATOMIC_RELAXED, __HIP_MEMORY_SCOPE_AGENT);
        }
        phase_xnorm(a, c);
    } else {
        phase_xnorm(a, c);
        if (threadIdx.x == 0) {
            unsigned sp = 0;
            while (__hip_atomic_load(wready, __ATOMIC_RELAXED, __HIP_MEMORY_SCOPE_AGENT) < (unsigned)c.GV) { __builtin_amdgcn_s_sleep(2); if (++sp > (1u << 22)) break; }
            __builtin_amdgcn_fence(__ATOMIC_ACQUIRE, "agent");
            asm volatile("s_waitcnt vmcnt(0)" ::: "memory");
        }
        __syncthreads();
    }
    xcd_barrier(gb);
    run_gemm<EpiProj, true>(lds, c, (const bf16_t*)(wsg + G_HN), (const bf16_t*)(ws + WS_WIN), 2048, 1024, EpiProj{(bf16_t*)(wsg + G_U3), (bf16_t*)(wsg + G_PROJ)});
    xcd_barrier(gb);
    phase_ssm(a, c, lds);
    xcd_barrier(gb);
    run_gemm(lds, c, (const bf16_t*)(wsg + G_YG), (const bf16_t*)(ws + WS_WGLU), 512, 512, EpiGlu{(const bf16_t*)(wsg + G_YG), (bf16_t*)(wsg + G_YCAT), a.in[13], (float*)(ws + WS_SS) + (size_t)c.grp * M_HALF});
    xcd_barrier(gb);
    phase_mix(a, c);
#if defined(PROBE_X2) && (PROBE_X2 & 2)
    if (c.grp == 1) phase_mix(a, c);
#endif
    xcd_barrier(gb);
    run_gemm(lds, c, (const bf16_t*)(wsg + G_YCAT), (const bf16_t*)(ws + WS_WOUT), 1024, 1024, EpiStoreBlk<0>{(bf16_t*)(wsg + G_O), 1024});
    xcd_barrier(gb);
    phase_resid6(a, c);
#if defined(PROBE_X2) && (PROBE_X2 & 2)
    if (c.grp == 1) phase_resid6(a, c);
#endif
    xcd_barrier(gb);
#ifdef PROBE_DUMMY
#pragma unroll 1
    for (int rp = 0; rp < 2; ++rp) {
        ProbeOrder S; S.init(M_HALF, 4096, c.GV, c.vb, 4); S.mode = rp;
        EpiStore<1> E{rp ? (bf16_t*)(ws + WS_END) : (bf16_t*)(wsg + G_H), 4096};
        pg8::gemm_phase<EpiStore<1>, ProbeOrder, true, true>((PG8_LAS unsigned char*)lds, pg8::Gemm{(const bf16_t*)(wsg + G_X1B), (const bf16_t*)(ws + WS_WUP), M_HALF, 4096, 1024}, S, E);
        xcd_barrier(gb);
    }
#elif defined(PROBE_UP2)
#pragma unroll 1
    for (int rp = 0; rp < (c.grp == 1 ? 2 : 1); ++rp) {
        run_gemm(lds, c, (const bf16_t*)(wsg + G_X1B), (const bf16_t*)(ws + WS_WUP), 4096, 1024, EpiStore<1>{(bf16_t*)(wsg + G_H), 4096});
        xcd_barrier(gb);
    }
#else
    run_gemm<EpiStoreBlk<1>, true>(lds, c, (const bf16_t*)(wsg + G_X1B), (const bf16_t*)(ws + WS_WUP), 4096, 1024, EpiStoreBlk<1>{(bf16_t*)(wsg + G_H), 4096});
    xcd_barrier(gb);
#endif
    run_gemm<EpiStoreBlk<0>, true>(lds, c, (const bf16_t*)(wsg + G_H), (const bf16_t*)(ws + WS_WDN), 1024, 4096, EpiStoreBlk<0>{(bf16_t*)(wsg + G_HN), 1024});
    xcd_barrier(gb);
    phase_final(a, c);
#if defined(PROBE_X2) && (PROBE_X2 & 2)
    if (c.grp == 1) phase_final(a, c);
#endif
}

extern "C" void kernel_launch(void* const* d_in, const int* in_sizes, int n_in, void* d_out, int out_size, void* d_ws, size_t ws_size, hipStream_t stream) {
    static int grid = 0;
    if (grid == 0) {
        if (n_in != 21 || in_sizes[0] != M_TOK * DM || out_size != M_TOK * DM || ws_size < WS_END) {
            fprintf(stderr, "kernel_launch: unexpected shapes (n_in %d, in0 %d, out %d, ws %zu < %zu)\n", n_in, n_in > 0 ? in_sizes[0] : -1, out_size, ws_size, (size_t)WS_END); grid = -1; return; }
        int dev = 0, cus = 0, per_cu = 0;
        (void)hipGetDevice(&dev); (void)hipDeviceGetAttribute(&cus, hipDeviceAttributeMultiprocessorCount, dev);
        if (hipFuncSetAttribute((const void*)hymba_fwd, hipFuncAttributeMaxDynamicSharedMemorySize, LDS_BYTES) != hipSuccess) fprintf(stderr, "kernel_launch: hipFuncSetAttribute failed\n");
        if (hipOccupancyMaxActiveBlocksPerMultiprocessor(&per_cu, (const void*)hymba_fwd, 512, LDS_BYTES) != hipSuccess || per_cu < 1) { fprintf(stderr, "kernel_launch: occupancy query says %d\n", per_cu); per_cu = 1; }
        (void)hipGetLastError();
        grid = cus * per_cu;
        if (grid > 256) grid = 256;
        grid &= ~15;
        if (grid < 16) { fprintf(stderr, "kernel_launch: grid %d too small\n", grid); grid = -1; return; }
    }
    if (grid < 0) return;
    Args a{};
    for (int i = 0; i < 21; ++i) a.in[i] = (const float*)d_in[i];
    a.out = (float*)d_out; a.ws = (unsigned char*)d_ws;
    a.ph_lo = 0; a.ph_hi = N_PHASES;
    if (hipMemsetAsync((unsigned char*)d_ws + WS_BAR, 0, BAR_BYTES, stream) != hipSuccess) { fprintf(stderr, "kernel_launch: memset of the barrier words failed\n"); return; }
    void* args[] = {&a};
    hipError_t e = hipLaunchCooperativeKernel((const void*)hymba_fwd, dim3(grid), dim3(512), args, LDS_BYTES, stream);
    if (e != hipSuccess) fprintf(stderr, "kernel_launch: cooperative launch failed: %s (grid %d)\n", hipGetErrorString(e), grid);
}
```

```cpp
#define MK_MULTI 0
#include <hip/hip_runtime.h>
namespace pg8 {
#define PG8_LAS __attribute__((address_space(3)))
typedef unsigned short bf16_t;
typedef short bf16x8 __attribute__((ext_vector_type(8)));
typedef float f32x4 __attribute__((ext_vector_type(4)));
typedef unsigned u32x4 __attribute__((ext_vector_type(4)));
constexpr int BM = 256, BK = 64, HALF = 128, HTB = HALF * BK * 2  , STAGE_BYTES = 8 * HTB, NXCD = 8, WGM = 8;

__host__ __device__ __forceinline__ int lds_byte(int r, int c) { const int st = (r >> 4) * 2 + (c >> 5), rr = r & 15, cc = c & 31, ob = rr * 64 + cc * 2; return st * 1024 + (ob ^ (((ob >> 9) & 1) << 5)); }
__host__ __device__ __forceinline__ void stage_rc(int b, int& R, int& C) { const int st = b / 1024, sb = b % 1024, swz = sb ^ (((sb >> 9) & 1) << 5); R = (st >> 1) * 16 + swz / 64; C = (st & 1) * 32 + (swz % 64) / 2; }
__host__ __device__ __forceinline__ int perm32(int rho) { const int n = rho >> 4, i = rho & 15; return 8 * (i >> 2) + 4 * n + (i & 3); }

struct Unit { int pm, pn; };
struct Gemm { const bf16_t* A; const bf16_t* Bt; int M, N, K; };

struct StaticOrder {
    int nM, nN, nwg, G, c, nx, rev;
    __host__ __device__ void init(int M, int N, int G_, int c_, int nx_ = NXCD, int rev_ = 0) { nM = M / BM; nN = N / BM; nwg = nM * nN; G = G_; c = c_; nx = nx_; rev = (rev_ && nwg % G_ == 0) ? 1 : 0; }
    __host__ __device__ bool next(int i, Unit& u) const {
        const long L = (long)(rev ? (nwg / G - 1 - i) : i) * G + c; if (L >= nwg || L < 0) return false;
        int wgid = (int)L; { const int q = nwg / nx, r = nwg % nx, xcd = wgid % nx, off = wgid / nx; wgid = (xcd < r ? xcd * (q + 1) : r * (q + 1) + (xcd - r) * q) + off; }
        const int nig = WGM * nN, gid = wgid / nig, fm = gid * WGM, gsz = (nM - fm) < WGM ? (nM - fm) : WGM;
        u.pm = fm + ((wgid % nig) % gsz); u.pn = (wgid % nig) / gsz; return true;
    }
    __device__ __forceinline__ void a_ready(const Unit&) const {}
    __device__ __forceinline__ void done(const Unit&) const {}
};
__device__ __forceinline__ unsigned cvt_pk_bf16(float lo, float hi) { unsigned r; asm("v_cvt_pk_bf16_f32 %0, %1, %2" : "=v"(r) : "v"(lo), "v"(hi)); return r; }
template <class Epi, class Sched, bool ALIGN_EPI = false, bool SP2 = false, bool ABLK = false>
__device__ __forceinline__ void gemm_phase(PG8_LAS unsigned char* lds, const Gemm g, const Sched& S, const Epi& E) {
    const int tid = threadIdx.x, wid = __builtin_amdgcn_readfirstlane(tid >> 6), lane = tid & 63, wr = wid >> 2, wc = wid & 3, fr = lane & 15, fq = lane >> 4;
    const int K = g.K, nt = K / BK;
    unsigned voffA[2], voffB[2];
#pragma unroll
    for (int i = 0; i < 2; ++i) { int R, C; stage_rc(tid * 16 + i * 8192, R, C); const int Rb = Epi::PERM ? ((R & ~31) + perm32(R & 31)) : R;
        voffA[i] = ABLK ? (unsigned)(((((R >> 4) * (K >> 5) + (C >> 5)) * 16 + (R & 15)) * 32 + (C & 31))) * 2u : (unsigned)(R * K + C) * 2u; voffB[i] = (unsigned)(Rb * K + C) * 2u; }
    const size_t kstep = (size_t)(BK * 2);
    const size_t kstepA = ABLK ? (size_t)2048 : kstep;
    const size_t hstep = (size_t)HALF * K * 2;
    const size_t tstep = 2 * hstep;
    const unsigned ldsw = (unsigned)wid * 1024u;
    const int aoff = lds_byte(wr * 64 + fr, fq * 8), boff = lds_byte(wc * 32 + fr, fq * 8);
#define PG8_SA(b, h) (((b) * 2 + (h)) * HTB)
#define PG8_SB(b, h) ((4 + (b) * 2 + (h)) * HTB)
#define PG8_STAGE(bufoff, gbase, voff) do { _Pragma("unroll") for (int _i = 0; _i < 2; ++_i) \
        __builtin_amdgcn_global_load_lds((const unsigned*)((const char*)(gbase) + (voff)[_i]), (PG8_LAS unsigned*)(lds + (bufoff) + ldsw + _i * 8192), 16, 0, 0); } while (0)
#define PG8_LDA(dst, b, h) do { _Pragma("unroll") for (int m = 0; m < 4; ++m) _Pragma("unroll") for (int k = 0; k < 2; ++k) dst[m][k] = *(const PG8_LAS bf16x8*)(lds + PG8_SA(b, h) + aoff + m * 2048 + k * 1024); } while (0)
#define PG8_LDB(dst, b, h) do { _Pragma("unroll") for (int n = 0; n < 2; ++n) _Pragma("unroll") for (int k = 0; k < 2; ++k) dst[n][k] = *(const PG8_LAS bf16x8*)(lds + PG8_SB(b, h) + boff + n * 2048 + k * 1024); } while (0)
#define PG8_MMA(ai, bj, At, Bt) do { __builtin_amdgcn_s_setprio(1); _Pragma("unroll") for (int m = 0; m < 4; ++m) _Pragma("unroll") for (int n = 0; n < 2; ++n) _Pragma("unroll") for (int k = 0; k < 2; ++k) \
        acc[ai][bj][m][n] = __builtin_amdgcn_mfma_f32_16x16x32_bf16(Bt[n][k], At[m][k], acc[ai][bj][m][n], 0, 0, 0); __builtin_amdgcn_s_setprio(0); } while (0)
#define PG8_MMAQ(ai, bj, At, Bt) do { _Pragma("unroll") for (int m = 0; m < 4; ++m) _Pragma("unroll") for (int n = 0; n < 2; ++n) _Pragma("unroll") for (int k = 0; k < 2; ++k) \
        acc[ai][bj][m][n] = __builtin_amdgcn_mfma_f32_16x16x32_bf16(Bt[n][k], At[m][k], acc[ai][bj][m][n], 0, 0, 0); } while (0)
#define PG8_WAIT_V(n) asm volatile("s_waitcnt vmcnt(" #n ")" ::: "memory")
#define PG8_WAIT_L(n) asm volatile("s_waitcnt lgkmcnt(" #n ")" ::: "memory")
#define PG8_BAR __builtin_amdgcn_s_barrier()
#define PG8_SCHED __builtin_amdgcn_sched_barrier(0)
    Unit cur, nxt; int ui = 0;
    if (!S.next(0, cur)) return;
    f32x4 acc[2][2][4][2];
#pragma unroll
    for (int a = 0; a < 2; ++a)
#pragma unroll
        for (int b = 0; b < 2; ++b)
#pragma unroll
            for (int m = 0; m < 4; ++m)
#pragma unroll
                for (int n = 0; n < 2; ++n) acc[a][b][m][n] = (f32x4){0.f, 0.f, 0.f, 0.f};
    bf16x8 At[4][2], B0[2][2], B1[2][2];
    const char* cA = (const char*)g.A + (size_t)cur.pm * tstep; const char* cB = (const char*)g.Bt + (size_t)cur.pn * tstep;
    S.a_ready(cur);
    if constexpr (SP2) {
        PG8_STAGE(PG8_SB(0, 0), cB, voffB); PG8_STAGE(PG8_SB(0, 1), cB + hstep, voffB); PG8_STAGE(PG8_SA(0, 0), cA, voffA); PG8_STAGE(PG8_SA(0, 1), cA + hstep, voffA);
        if (wr == 1) PG8_BAR;
        PG8_WAIT_V(2); PG8_BAR;
        PG8_STAGE(PG8_SB(1, 0), cB + kstep, voffB); PG8_STAGE(PG8_SA(1, 0), cA + kstepA, voffA); PG8_STAGE(PG8_SB(1, 1), cB + hstep + kstep, voffB);
        PG8_WAIT_V(6); PG8_BAR;
    } else {
        PG8_STAGE(PG8_SB(0, 0), cB, voffB); PG8_STAGE(PG8_SA(0, 0), cA, voffA); PG8_STAGE(PG8_SB(0, 1), cB + hstep, voffB); PG8_STAGE(PG8_SA(0, 1), cA + hstep, voffA);
        if (wr == 1) PG8_BAR;
        PG8_WAIT_V(4); PG8_BAR;
        PG8_STAGE(PG8_SB(1, 0), cB + kstep, voffB); PG8_STAGE(PG8_SA(1, 0), cA + kstepA, voffA); PG8_STAGE(PG8_SB(1, 1), cB + hstep + kstep, voffB);
        PG8_WAIT_V(6); PG8_BAR;
    }
    for (;;) {
        const bool has_next = S.next(ui + 1, nxt);
        const char* nA = has_next ? (const char*)g.A + (size_t)nxt.pm * tstep : cA; const char* nB = has_next ? (const char*)g.Bt + (size_t)nxt.pn * tstep : cB;
        for (int t = 0; t < nt; t += 2) {
            const bool last = (t == nt - 2);
            const char* a1 = cA + (size_t)(t + 1) * kstepA;
            const char* a2 = last ? nA : cA + (size_t)(t + 2) * kstepA; const char* b2 = last ? nB : cB + (size_t)(t + 2) * kstep;
            const char* a3 = a2 + kstepA; const char* b3 = b2 + kstep;
            if (last && has_next) S.a_ready(nxt);
            if constexpr (SP2) {
            PG8_LDB(B0, 0, 0); PG8_LDB(B1, 0, 1); PG8_SCHED; PG8_LDA(At, 0, 0); PG8_STAGE(PG8_SA(1, 1), a1 + hstep, voffA);
            PG8_WAIT_V(8); PG8_WAIT_L(0); PG8_BAR; __builtin_amdgcn_s_setprio(1); PG8_MMAQ(0, 0, At, B0); PG8_MMAQ(0, 1, At, B1); __builtin_amdgcn_s_setprio(0); PG8_BAR; PG8_SCHED;
            PG8_LDA(At, 0, 1); PG8_STAGE(PG8_SB(0, 0), b2, voffB); PG8_STAGE(PG8_SB(0, 1), b2 + hstep, voffB); PG8_STAGE(PG8_SA(0, 0), a2, voffA);
            PG8_WAIT_V(8); PG8_WAIT_L(0); PG8_BAR; __builtin_amdgcn_s_setprio(1); PG8_MMAQ(1, 0, At, B0); PG8_MMAQ(1, 1, At, B1); __builtin_amdgcn_s_setprio(0); PG8_BAR; PG8_SCHED;
            PG8_LDB(B0, 1, 0); PG8_LDB(B1, 1, 1); PG8_SCHED; PG8_LDA(At, 1, 0); PG8_STAGE(PG8_SA(0, 1), a2 + hstep, voffA);
            PG8_WAIT_V(8); PG8_WAIT_L(0); PG8_BAR; __builtin_amdgcn_s_setprio(1); PG8_MMAQ(0, 0, At, B0); PG8_MMAQ(0, 1, At, B1); __builtin_amdgcn_s_setprio(0); PG8_BAR; PG8_SCHED;
            PG8_LDA(At, 1, 1); PG8_STAGE(PG8_SB(1, 0), b3, voffB); PG8_STAGE(PG8_SB(1, 1), b3 + hstep, voffB); PG8_STAGE(PG8_SA(1, 0), a3, voffA);
            PG8_WAIT_V(8); PG8_WAIT_L(0); PG8_BAR; __builtin_amdgcn_s_setprio(1); PG8_MMAQ(1, 0, At, B0); PG8_MMAQ(1, 1, At, B1); __builtin_amdgcn_s_setprio(0); PG8_BAR; PG8_SCHED;
            } else {
            PG8_LDB(B0, 0, 0); PG8_SCHED; PG8_LDA(At, 0, 0); PG8_STAGE(PG8_SA(1, 1), a1 + hstep, voffA);
            PG8_WAIT_L(8); PG8_BAR; PG8_WAIT_L(0); PG8_MMA(0, 0, At, B0); PG8_BAR; PG8_SCHED;
            PG8_LDB(B1, 0, 1); PG8_STAGE(PG8_SB(0, 0), b2, voffB);
            PG8_BAR; PG8_WAIT_L(0); PG8_MMA(0, 1, At, B1); PG8_BAR;
            PG8_LDA(At, 0, 1); PG8_STAGE(PG8_SA(0, 0), a2, voffA);
            PG8_BAR; PG8_WAIT_L(0); PG8_MMA(1, 0, At, B0); PG8_BAR; PG8_SCHED;
            PG8_STAGE(PG8_SB(0, 1), b2 + hstep, voffB);
            PG8_WAIT_V(6); PG8_BAR; PG8_MMA(1, 1, At, B1); PG8_BAR;
            PG8_LDB(B0, 1, 0); PG8_SCHED; PG8_LDA(At, 1, 0); PG8_STAGE(PG8_SA(0, 1), a2 + hstep, voffA);
            PG8_WAIT_L(8); PG8_BAR; PG8_WAIT_L(0); PG8_MMA(0, 0, At, B0); PG8_BAR; PG8_SCHED;
            PG8_LDB(B1, 1, 1); PG8_STAGE(PG8_SB(1, 0), b3, voffB);
            PG8_BAR; PG8_WAIT_L(0); PG8_MMA(0, 1, At, B1); PG8_BAR;
            PG8_LDA(At, 1, 1); PG8_STAGE(PG8_SA(1, 0), a3, voffA);
            PG8_BAR; PG8_WAIT_L(0); PG8_MMA(1, 0, At, B0); PG8_BAR; PG8_SCHED;
            PG8_STAGE(PG8_SB(1, 1), b3 + hstep, voffB);
            PG8_WAIT_V(6); PG8_BAR; PG8_MMA(1, 1, At, B1); PG8_BAR;
            }
        }
        if constexpr (ALIGN_EPI) { if (wr == 0) PG8_BAR; }
        if constexpr (!Epi::AFTER_DRAIN) { E(acc, cur, wr, wc, fr, fq); S.done(cur); }
        if (!has_next) break;
#pragma unroll
        for (int a = 0; a < 2; ++a)
#pragma unroll
            for (int b = 0; b < 2; ++b)
#pragma unroll
                for (int m = 0; m < 4; ++m)
#pragma unroll
                    for (int n = 0; n < 2; ++n) acc[a][b][m][n] = (f32x4){0.f, 0.f, 0.f, 0.f};
        cur = nxt; cA = nA; cB = nB; ++ui;
        if constexpr (ALIGN_EPI) { if (wr == 1) PG8_BAR; }
    }
    PG8_WAIT_V(0);
    if constexpr (!ALIGN_EPI) { if (wr == 0) PG8_BAR; }
    PG8_BAR;
    if constexpr (Epi::AFTER_DRAIN) { E.fused(acc, cur, wr, wc, fr, fq, lds, wid, lane); S.done(cur); }
#undef PG8_SA
#undef PG8_SB
#undef PG8_STAGE
#undef PG8_LDA
#undef PG8_LDB
#undef PG8_MMA
#undef PG8_MMAQ
#undef PG8_WAIT_V
#undef PG8_WAIT_L
#undef PG8_BAR
#undef PG8_SCHED
}
}

#include <hip/hip_cooperative_groups.h>
#include <cstdio>
#include <cstdint>
namespace cg = cooperative_groups;
using pg8::bf16_t; using pg8::bf16x8; using pg8::f32x4; using pg8::u32x4; using pg8::cvt_pk_bf16;
typedef unsigned u32;
typedef u32 u32x2 __attribute__((ext_vector_type(2)));
typedef float f32x16 __attribute__((ext_vector_type(16)));
typedef float f32x2_t __attribute__((ext_vector_type(2)));

#ifndef MK_MULTI
#define MK_MULTI 0
#endif
#define LAS __attribute__((address_space(3)))
#define XB_TMO      128
#define XB_XCNT(j)  (256  + 64 * (j))
#define XB_XSUB(j)  (1280 + 64 * (j))
#define XB_XGEN(j)  (2304 + 64 * (j))
#define XB_TOP      3328
#define XB_TOPGEN   3392
#define XCD_BAR_WORDS 3456
#define XB_SPIN_CAP (1u << 18)

__device__ __forceinline__ unsigned xb_ld(unsigned* p)              { return __hip_atomic_load(p, __ATOMIC_RELAXED, __HIP_MEMORY_SCOPE_AGENT); }
__device__ __forceinline__ unsigned xb_add(unsigned* p, unsigned v) { return __hip_atomic_fetch_add(p, v, __ATOMIC_RELAXED, __HIP_MEMORY_SCOPE_AGENT); }
__device__ __forceinline__ unsigned xb_xcc_id() { return (unsigned)__builtin_amdgcn_s_getreg((3 << 11) | 20) & 0xFu; }
#define XB_SPIN(cond, bar) do { unsigned _sp = 0; while (cond) { __builtin_amdgcn_s_sleep(1); \
    if ((++_sp & 255u) == 0u) { if (xb_ld(&(bar)[XB_TMO])) break; if (_sp > XB_SPIN_CAP) { atomicAdd(&(bar)[XB_TMO], 1u); break; } } } } while (0)

struct XcdBarrier {
    unsigned* bar; unsigned x; unsigned G;
    volatile LAS unsigned* st;
};

__device__ __forceinline__ XcdBarrier xcd_barrier_post(unsigned* bar, volatile LAS unsigned* st, unsigned G) {
    XcdBarrier b; b.bar = bar; b.x = xb_xcc_id(); b.st = st; b.G = G;
    if (threadIdx.x == 0) (void)xb_add(&bar[XB_XCNT(b.x)], 1u);
    return b;
}
__device__ __forceinline__ void xcd_barrier_complete(unsigned* bar, unsigned x, const unsigned G, unsigned& nloc, unsigned& nx) {
    unsigned sum, cnt, mine, sp = 0u;
    for (;;) {
        sum = 0u; cnt = 0u; mine = 0u;
#pragma unroll
        for (unsigned j = 0; j < 16; ++j) { const unsigned c = xb_ld(&bar[XB_XCNT(j)]); sum += c; cnt += (c > 0u) ? 1u : 0u; mine = (j == x) ? c : mine; }
        if (sum == G) break;
        __builtin_amdgcn_s_sleep(1);
        if ((++sp & 255u) == 0u) { if (xb_ld(&bar[XB_TMO])) break; if (sp > XB_SPIN_CAP) { atomicAdd(&bar[XB_TMO], 1u); break; } }
    }
    nloc = mine > 0u ? mine : 1u; nx = cnt > 0u ? cnt : 1u;
}

__device__ __forceinline__ void xcd_barrier(const XcdBarrier& b) {
    asm volatile("s_waitcnt vmcnt(0)" ::: "memory");
    __syncthreads();
    if (threadIdx.x == 0) {
        unsigned* bar = b.bar;
        __builtin_amdgcn_s_waitcnt(0);
        unsigned nloc = b.st[0], nx = b.st[1];
        if (nloc == 0u) { xcd_barrier_complete(bar, b.x, b.G, nloc, nx); b.st[0] = nloc; b.st[1] = nx; }
        const unsigned old = xb_add(&bar[XB_XSUB(b.x)], 1u);
        const unsigned gen = old / nloc;
        if (old + 1u == (gen + 1u) * nloc) {
            __builtin_amdgcn_fence(__ATOMIC_RELEASE, "agent");
            asm volatile("s_waitcnt vmcnt(0)" ::: "memory");
            const unsigned og = xb_add(&bar[XB_TOP], 1u);
            const unsigned tg = og / nx;
            if (og + 1u == (tg + 1u) * nx) xb_add(&bar[XB_TOPGEN], 1u);
            else XB_SPIN(xb_ld(&bar[XB_TOPGEN]) == tg, bar);
            __builtin_amdgcn_fence(__ATOMIC_ACQUIRE, "agent");
            xb_add(&bar[XB_XGEN(b.x)], 1u);
            asm volatile("s_waitcnt vmcnt(0)" ::: "memory");
        } else {
            XB_SPIN(xb_ld(&bar[XB_XGEN(b.x)]) == gen, bar);
            __builtin_amdgcn_fence(__ATOMIC_ACQUIRE, "agent");
            asm volatile("s_waitcnt vmcnt(0)" ::: "memory");
        }
    }
    __syncthreads();
}


constexpr int M_TOK = 65536, DM = 1024, SEQ = 8192;
constexpr int N_PHASES = 10;
constexpr int LDS_BYTES = 147456;
constexpr float RMS_EPS = 1e-6f;

constexpr size_t MiB = 1024ull * 1024ull;
constexpr size_t WS_WIN = 0, WS_WGLU = 4 * MiB, WS_WOUT = 5 * MiB, WS_WUP = 8 * MiB, WS_WDN = 16 * MiB;
constexpr size_t WS_TWST = 24 * MiB, WS_TWOUT = 26 * MiB, WS_TKT = 28 * MiB, WS_TSC = 29 * MiB, WS_BAR = 30 * MiB;
constexpr size_t WS_SS = 31 * MiB;
constexpr size_t WS_RINV = 31 * MiB + 512 * 1024;
constexpr size_t BAR_STRIDE = 16384, BAR_BYTES = 3 * BAR_STRIDE;
constexpr int LDS_ST_OFF = 147440;
constexpr size_t WS_GROUP0 = 32 * MiB, GROUP_BYTES = 464 * MiB;
constexpr size_t G_X1B = 0  , G_SWS = 0, G_CWS = 32 * MiB, G_U3 = 48 * MiB, G_HN = 80 * MiB, G_O = 144 * MiB, G_BIG = 208 * MiB;
constexpr size_t G_PROJ = G_BIG, G_YG = G_BIG + 96 * MiB, G_YGLU = G_BIG + 128 * MiB, G_YCAT = G_BIG + 160 * MiB, G_H = G_BIG;
constexpr size_t WS_END = WS_GROUP0 + 2 * GROUP_BYTES;
constexpr int KT_ELEMS = 17 * 256, KT_PLANE = 17 * 128;
constexpr int M_HALF = M_TOK / 2;

struct Ctx { int grp, vb, GV, m0; unsigned char* wsg; };

struct Args { const float* in[21]; float* out; unsigned char* ws; int ph_lo, ph_hi; };

__device__ __forceinline__ float bf_lo(u32 w) { return __uint_as_float(w << 16); }
__device__ __forceinline__ float bf_hi(u32 w) { return __uint_as_float(w & 0xffff0000u); }
__device__ __forceinline__ bf16_t f2bf(float f) { return (bf16_t)(cvt_pk_bf16(f, 0.f) & 0xffffu); }
__device__ __forceinline__ float wave_sum(float v) {
#pragma unroll
    for (int o = 1; o < 64; o <<= 1) v += __shfl_xor(v, o);
    return v;
}
__device__ __forceinline__ float fast_rcp(float x) { return __builtin_amdgcn_rcpf(x); }
__device__ __forceinline__ float sigmoidf_(float v) { return fast_rcp(1.f + __expf(-v)); }
__device__ __forceinline__ float gelu_tanh(float v) {
    const float t = v * (-2.3022082f + -0.10294324f * (v * v)); return v * fast_rcp(1.f + __builtin_amdgcn_exp2f(t)); }

struct EpiProj {
    static constexpr bool PERM = true, AFTER_DRAIN = false;
    bf16_t* U3; bf16_t* P;
    __device__ __forceinline__ void operator()(const f32x4 (&acc)[2][2][4][2], const pg8::Unit& u, int wr, int wc, int fr, int fq) const {
        const int row0 = u.pm * 256 + wr * 64 + fr, colb = u.pn * 256 + wc * 32 + 8 * fq;
#pragma unroll
        for (int ai = 0; ai < 2; ++ai)
#pragma unroll
            for (int m = 0; m < 4; ++m) {
                const int row = row0 + ai * 128 + m * 16;
                if (u.pn >= 2 && u.pn < 6) {
                    const f32x4 h0 = acc[ai][0][m][0], c0 = acc[ai][0][m][1], h1 = acc[ai][1][m][0], c1 = acc[ai][1][m][1];
                    u32x4 z; z.x = cvt_pk_bf16(h0[0] * c0[0], h0[1] * c0[1]); z.y = cvt_pk_bf16(h0[2] * c0[2], h0[3] * c0[3]); z.z = cvt_pk_bf16(h1[0] * c1[0], h1[1] * c1[1]); z.w = cvt_pk_bf16(h1[2] * c1[2], h1[3] * c1[3]);
                    *(u32x4*)(P + (size_t)row * 1024 + (u.pn - 2) * 128 + wc * 32 + 8 * fq) = z;
                } else {
#pragma unroll
                    for (int bj = 0; bj < 2; ++bj) {
                        const int col = colb + bj * 128;
                        const f32x4 v0 = acc[ai][bj][m][0], v1 = acc[ai][bj][m][1];
                        u32x4 w; w.x = cvt_pk_bf16(v0[0], v0[1]); w.y = cvt_pk_bf16(v0[2], v0[3]); w.z = cvt_pk_bf16(v1[0], v1[1]); w.w = cvt_pk_bf16(v1[2], v1[3]);
                        if (u.pn < 2) {
                            const int b = row >> 13, tl = row & 8191, g = col >> 4, hf = (col >> 3) & 1;
                            const size_t off = (((size_t)(b * 32 + g) * 8192 + tl) * 2 + hf) * 8;
                            *(u32x4*)(U3 + off) = w;
                        } else {
                            *(u32x4*)(P + (size_t)row * 1024 + 512 + (col - 1536)) = w;
                        }
                    }
                }
            }
    }
};
template <int ACT  > struct EpiStore {
    static constexpr bool PERM = true, AFTER_DRAIN = false;
    bf16_t* O; int ldc;
    __device__ __forceinline__ void operator()(const f32x4 (&acc)[2][2][4][2], const pg8::Unit& u, int wr, int wc, int fr, int fq) const {
        const int row0 = u.pm * 256 + wr * 64 + fr, colb = u.pn * 256 + wc * 32 + 8 * fq;
#pragma unroll
        for (int ai = 0; ai < 2; ++ai)
#pragma unroll
            for (int m = 0; m < 4; ++m) {
                bf16_t* rowp = O + (size_t)(row0 + ai * 128 + m * 16) * ldc + colb;
#pragma unroll
                for (int bj = 0; bj < 2; ++bj) {
                    f32x4 v0 = acc[ai][bj][m][0], v1 = acc[ai][bj][m][1];
                    if (ACT == 1) {
#pragma unroll
                        for (int j = 0; j < 4; ++j) {
                            float a0, a1; asm("v_max_f32 %0, 0, %1" : "=v"(a0) : "v"(v0[j])); asm("v_max_f32 %0, 0, %1" : "=v"(a1) : "v"(v1[j]));
                            f32x2_t p = (f32x2_t){a0, a1}; p = p * p; v0[j] = p.x; v1[j] = p.y; }
                    }
                    u32x4 w; w.x = cvt_pk_bf16(v0[0], v0[1]); w.y = cvt_pk_bf16(v0[2], v0[3]); w.z = cvt_pk_bf16(v1[0], v1[1]); w.w = cvt_pk_bf16(v1[2], v1[3]);
                    *(u32x4*)(rowp + bj * 128) = w;
                }
            }
    }
};
template <int ACT  > struct EpiStoreBlk {
    static constexpr bool PERM = true, AFTER_DRAIN = false;
    bf16_t* O; int ldc;
    __device__ __forceinline__ void operator()(const f32x4 (&acc)[2][2][4][2], const pg8::Unit& u, int wr, int wc, int fr, int fq) const {
        const int rb0 = u.pm * 16 + wr * 4, cb0 = u.pn * 8 + wc, cbs = ldc >> 5;
#pragma unroll
        for (int ai = 0; ai < 2; ++ai)
#pragma unroll
            for (int m = 0; m < 4; ++m) {
#pragma unroll
                for (int bj = 0; bj < 2; ++bj) {
                    f32x4 v0 = acc[ai][bj][m][0], v1 = acc[ai][bj][m][1];
                    if (ACT == 1) {
#pragma unroll
                        for (int j = 0; j < 4; ++j) {
                            float a0, a1; asm("v_max_f32 %0, 0, %1" : "=v"(a0) : "v"(v0[j])); asm("v_max_f32 %0, 0, %1" : "=v"(a1) : "v"(v1[j]));
                            f32x2_t p = (f32x2_t){a0, a1}; p = p * p; v0[j] = p.x; v1[j] = p.y; }
                    }
                    u32x4 w; w.x = cvt_pk_bf16(v0[0], v0[1]); w.y = cvt_pk_bf16(v0[2], v0[3]); w.z = cvt_pk_bf16(v1[0], v1[1]); w.w = cvt_pk_bf16(v1[2], v1[3]);
                    const size_t off = (((size_t)(rb0 + ai * 8 + m) * cbs + (cb0 + bj * 4)) * 16 + fr) * 32 + 8 * fq;
                    *(u32x4*)(O + off) = w;
                }
            }
    }
};
struct EpiGlu {
    static constexpr bool PERM = true, AFTER_DRAIN = false;
    const bf16_t* Y; bf16_t* O; const float* gs; float* SS;
    __device__ __forceinline__ void operator()(const f32x4 (&acc)[2][2][4][2], const pg8::Unit& u, int wr, int wc, int fr, int fq) const {
        const int row0 = u.pm * 256 + wr * 64 + fr, colb = u.pn * 256 + wc * 32 + 8 * fq;
        f32x4 g[2][2];
#pragma unroll
        for (int bj = 0; bj < 2; ++bj) { g[bj][0] = *(const f32x4*)(gs + colb + bj * 128); g[bj][1] = *(const f32x4*)(gs + colb + bj * 128 + 4); }
#pragma unroll
        for (int ai = 0; ai < 2; ++ai)
#pragma unroll
            for (int m = 0; m < 4; ++m) {
                const int row = row0 + ai * 128 + m * 16;
                float ss = 0.f;
#pragma unroll
                for (int bj = 0; bj < 2; ++bj) {
                    const f32x4 v0 = acc[ai][bj][m][0], v1 = acc[ai][bj][m][1];
                    const u32x4 y = *(const u32x4*)(Y + (size_t)row * 512 + colb + bj * 128);
                    f32x4 t0, t1;
                    t0[0] = bf_lo(y.x) * sigmoidf_(v0[0]); t0[1] = bf_hi(y.x) * sigmoidf_(v0[1]); t0[2] = bf_lo(y.y) * sigmoidf_(v0[2]); t0[3] = bf_hi(y.y) * sigmoidf_(v0[3]);
                    t1[0] = bf_lo(y.z) * sigmoidf_(v1[0]); t1[1] = bf_hi(y.z) * sigmoidf_(v1[1]); t1[2] = bf_lo(y.w) * sigmoidf_(v1[2]); t1[3] = bf_hi(y.w) * sigmoidf_(v1[3]);
                    ss += (t0[0] * t0[0] + t0[1] * t0[1]) + (t0[2] * t0[2] + t0[3] * t0[3]) + (t1[0] * t1[0] + t1[1] * t1[1]) + (t1[2] * t1[2] + t1[3] * t1[3]);
                    t0 = t0 * g[bj][0]; t1 = t1 * g[bj][1];
                    u32x4 w; w.x = cvt_pk_bf16(t0[0], t0[1]); w.y = cvt_pk_bf16(t0[2], t0[3]); w.z = cvt_pk_bf16(t1[0], t1[1]); w.w = cvt_pk_bf16(t1[2], t1[3]);
                    *(u32x4*)(O + (size_t)row * 1024 + colb + bj * 128) = w;
                }
                ss += __shfl_xor(ss, 16); ss += __shfl_xor(ss, 32);
                if (fq == 0) unsafeAtomicAdd(SS + row, ss);
            }
    }
};

__device__ __forceinline__ void cpowd(double lrdt, double lidt, double k, float& re, float& im) {
    const double mag = exp(lrdt * k);
    double ang = lidt * k;
    ang -= 6.283185307179586476925 * rint(ang * 0.15915494309189533577);
    re = (float)(mag * cos(ang)); im = (float)(mag * sin(ang));
}
__device__ __forceinline__ void transpose_item(const float* W, int K, int N, bf16_t* WT, float* scr, int item, int lane, const float* gk = nullptr, bool win_map = false) {
    const int nblk = N / 32, kb = item / nblk, nb = item % nblk, k0 = 64 * kb, n0 = 32 * nb;
#pragma unroll 8
    for (int i = 0; i < 32; ++i) { const int kk = 2 * i + (lane >> 5); float w = W[(size_t)(k0 + kk) * N + n0 + (lane & 31)]; if (gk) w *= gk[k0 + kk]; scr[kk * 33 + (lane & 31)] = w; }
    __builtin_amdgcn_s_waitcnt(0xc07f); asm volatile("" ::: "memory");
    const int c = lane & 7;
#pragma unroll
    for (int j = 0; j < 4; ++j) { const int n = (lane >> 3) + 8 * j; const float* s = scr + (8 * c) * 33 + n;
        u32x4 o; o.x = cvt_pk_bf16(s[0 * 33], s[1 * 33]); o.y = cvt_pk_bf16(s[2 * 33], s[3 * 33]); o.z = cvt_pk_bf16(s[4 * 33], s[5 * 33]); o.w = cvt_pk_bf16(s[6 * 33], s[7 * 33]);
        int nr = n0 + n;
        if (win_map && nr >= 512) {
            if (nr < 1024 || nr >= 1536) { const int nn = nr >= 1536, ch = nr - (nn ? 1536 : 512), r = ch & 127;
                nr = 512 + 256 * (ch >> 7) + 128 * ((r >> 2) & 1) + 32 * (r >> 5) + 8 * ((r >> 3) & 3) + 4 * nn + (r & 3); }
            else nr = nr + 512;
        }
        *(u32x4*)(WT + (size_t)nr * K + k0 + 8 * c) = o; }
    __builtin_amdgcn_s_waitcnt(0xc07f); asm volatile("" ::: "memory");
}
__device__ __forceinline__ void phase_prep_w(const Args& a, const Ctx& c, unsigned char* lds) {
    const int tid = threadIdx.x, lane = tid & 63, wave = tid >> 6;
    const int gw = c.vb * 8 + wave, NGW = c.GV * 8;
    unsigned char* ws = a.ws;
    {
        const float* lam_re = a.in[3]; const float* lam_im = a.in[4]; const float* log_dt = a.in[5];
        const float* b_re = a.in[6]; const float* b_im = a.in[7]; const float* c_re = a.in[8]; const float* c_im = a.in[9]; const float* d_skip = a.in[10];
        float2* shpow = (float2*)(lds + 69632);
        float2* shcoef = (float2*)(lds + 69632 + 6144);
        float2* shB = (float2*)(lds + 69632 + 8192);
        float2* shC = (float2*)(lds + 69632 + 16384);
        bf16_t* TWST = (bf16_t*)(ws + WS_TWST); bf16_t* TWOUT = (bf16_t*)(ws + WS_TWOUT); bf16_t* TKT = (bf16_t*)(ws + WS_TKT); float4* TSC = (float4*)(ws + WS_TSC);
        for (int it = c.vb; it < 128; it += c.GV) {
            const int g = it >> 2, jq = it & 3;
            if (tid < 256) {
                const int p = tid & 63, jj = tid >> 6, j = 4 * jq + jj;
                const double dt = exp((double)log_dt[g]);
                const double lr = (double)lam_re[g * 64 + p], li = (double)lam_im[g * 64 + p];
                const double lrdt = lr * dt, lidt = li * dt;
                const double mag = exp(lrdt); double ang = lidt; ang -= 6.283185307179586476925 * rint(ang * 0.15915494309189533577);
                const double a1r = mag * cos(ang), a1i = mag * sin(ang);
                double pjr = 1.0, pji = 0.0, pqr = 1.0, pqi = 0.0;
                for (int k = 0; k < j; ++k) { const double t = pjr * a1r - pji * a1i; pji = pjr * a1i + pji * a1r; pjr = t; }
                for (int k = 0; k < 15 - j; ++k) { const double t = pqr * a1r - pqi * a1i; pqi = pqr * a1i + pqi * a1r; pqr = t; }
                const double p1r = pjr * a1r - pji * a1i, p1i = pjr * a1i + pji * a1r;
                shpow[(jj * 3 + 0) * 64 + p] = make_float2((float)pjr, (float)pji); shpow[(jj * 3 + 1) * 64 + p] = make_float2((float)pqr, (float)pqi); shpow[(jj * 3 + 2) * 64 + p] = make_float2((float)p1r, (float)p1i);
                if (jj == 0) {
                    const double nr = a1r - 1.0, ni = a1i, den = lr * lr + li * li;
                    shcoef[p] = make_float2((float)((nr * lr + ni * li) / den), (float)((ni * lr - nr * li) / den));
                    if (jq == 0) {
                        const double s16r = p1r * pqr - p1i * pqi, s16i = p1r * pqi + p1i * pqr;
                        double br = s16r, bi = s16i;
#pragma unroll
                        for (int k = 0; k < 6; ++k) { const double t = br * br - bi * bi; bi = 2.0 * br * bi; br = t; }
                        TSC[g * 64 + p] = make_float4((float)s16r, (float)s16i, (float)br, (float)bi);
                    }
                }
            }
            __syncthreads();
#pragma unroll
            for (int i = 0; i < 2; ++i) {
                const int e = tid + 512 * i;
                { const int p = e >> 4; const float2 co = shcoef[p]; const float br = b_re[g * 1024 + e], bi = b_im[g * 1024 + e]; shB[e] = make_float2(co.x * br - co.y * bi, co.x * bi + co.y * br); }
                shC[e] = make_float2(c_re[g * 1024 + e], c_im[g * 1024 + e]);
            }
            __syncthreads();
#pragma unroll
            for (int i = 0; i < 2; ++i) {
                const int e = tid + 512 * i, jj = e >> 8, hp = (e >> 4) & 15, h = e & 15, j = 4 * jq + jj; float val = 0.f;
#pragma unroll 8
                for (int p = 0; p < 64; ++p) {
                    const float2 A = shpow[(jj * 3 + 0) * 64 + p], bb = shB[p * 16 + h], cc = shC[hp * 64 + p];
                    const float tr = A.x * bb.x - A.y * bb.y, ti = A.x * bb.y + A.y * bb.x;
                    val += cc.x * tr - cc.y * ti;
                }
                if (j == 0 && hp == h) val += d_skip[g * 16 + hp];
                TKT[(size_t)g * KT_ELEMS + (h >> 3) * KT_PLANE + (1 + j) * 128 + hp * 8 + (h & 7)] = f2bf(val);
                if (jq == 0 && e < 256) TKT[(size_t)g * KT_ELEMS + (e >> 7) * KT_PLANE + (e & 127)] = 0;
            }
#pragma unroll 1
            for (int jj = 0; jj < 4; ++jj) {
                const int j = 4 * jq + jj;
#pragma unroll
                for (int i = 0; i < 4; ++i) {
                    const int e = tid + 512 * i;
                    {
                        const int h = e & 15, col = e >> 4, cidx = col >> 6, p = col & 63;
                        const float2 A = shpow[(jj * 3 + 1) * 64 + p], bb = shB[p * 16 + h];
                        const float tr = A.x * bb.x - A.y * bb.y, ti = A.x * bb.y + A.y * bb.x;
                        TWST[(size_t)g * 32768 + j * 2048 + (col >> 5) * 512 + (h >> 3) * 256 + (col & 31) * 8 + (h & 7)] = f2bf(cidx ? ti : tr);
                    }
                    {
                        const int hp = e & 15, p = (e >> 4) & 63, cidx = e >> 10;
                        const float2 A = shpow[(jj * 3 + 2) * 64 + p], cc = shC[hp * 64 + p];
                        const float tr = cc.x * A.x - cc.y * A.y, ti = cc.x * A.y + cc.y * A.x;
                        const int ni = j >> 1, n = (j & 1) * 16 + hp, kk = cidx * 4 + (p >> 4), k = p & 15;
                        TWOUT[(size_t)g * 32768 + (kk * 8 + ni) * 512 + (k >> 3) * 256 + n * 8 + (k & 7)] = f2bf(cidx ? -ti : tr);
                    }
                }
            }
            __syncthreads();
        }
    }
    {
        float* scr = (float*)(lds + wave * 8448);
        constexpr int I_IN = 16 * 64, I_GLU = 8 * 16, I_OUT = 16 * 32, I_UP = 16 * 128, I_DN = 64 * 32;
        constexpr int NITEMS = I_IN + I_GLU + I_OUT + I_UP + I_DN;
        for (int it = gw; it < NITEMS; it += NGW) {
            int r = it;
            if (r < I_IN) { transpose_item(a.in[2], 1024, 2048, (bf16_t*)(ws + WS_WIN), scr, r, lane, nullptr, true); continue; } r -= I_IN;
            if (r < I_GLU) { transpose_item(a.in[11], 512, 512, (bf16_t*)(ws + WS_WGLU), scr, r, lane); continue; } r -= I_GLU;
            if (r < I_OUT) { transpose_item(a.in[15], 1024, 1024, (bf16_t*)(ws + WS_WOUT), scr, r, lane); continue; } r -= I_OUT;
            if (r < I_UP) { transpose_item(a.in[18], 1024, 4096, (bf16_t*)(ws + WS_WUP), scr, r, lane, a.in[17]); continue; } r -= I_UP;
            transpose_item(a.in[19], 4096, 1024, (bf16_t*)(ws + WS_WDN), scr, r, lane);
        }
    }
}
__device__ __forceinline__ float pair_sum(float v) {
    v += __shfl_xor(v, 1); v += __shfl_xor(v, 2); v += __shfl_xor(v, 4); v += __shfl_xor(v, 16); v += __shfl_xor(v, 32); return v;
}
__device__ __forceinline__ void phase_xnorm(const Args& a, const Ctx& c) {
    const int tid = threadIdx.x, lane = tid & 63, wave = tid >> 6;
    const int gw = c.vb * 8 + wave, NGW = c.GV * 8;
    { float* SS = (float*)(a.ws + WS_SS) + (size_t)c.grp * M_HALF; for (int i = c.vb * 512 + tid; i < M_HALF; i += c.GV * 512) SS[i] = 0.f; }
    const float* x = a.in[0] + (size_t)c.m0 * DM; const float* gp = a.in[1]; bf16_t* HN = (bf16_t*)(c.wsg + G_HN); float* RINV = (float*)(a.ws + WS_RINV) + (size_t)c.grp * M_HALF;
    const int sub = (lane >> 3) & 1, cl = 32 * (lane >> 4) + 4 * (lane & 7);
    f32x4 gv[8];
#pragma unroll
    for (int j = 0; j < 8; ++j) gv[j] = *(const f32x4*)(gp + cl + 128 * j);
    f32x4 v[8], nx[8];
#pragma unroll
    for (int j = 0; j < 8; ++j) v[j] = __builtin_nontemporal_load((const f32x4*)(x + (size_t)(2 * gw + sub) * DM + cl + 128 * j));
    for (int pr = gw; pr < M_HALF / 2; pr += NGW) {
        const int pn = pr + NGW, r = 2 * pr;
        if (pn < M_HALF / 2) {
#pragma unroll
            for (int j = 0; j < 8; ++j) nx[j] = __builtin_nontemporal_load((const f32x4*)(x + (size_t)(2 * pn + sub) * DM + cl + 128 * j));
        }
        float ss = 0.f;
#pragma unroll
        for (int j = 0; j < 8; ++j) ss += (v[j].x * v[j].x + v[j].y * v[j].y) + (v[j].z * v[j].z + v[j].w * v[j].w);
        const float q = pair_sum(ss) * (1.f / DM) + RMS_EPS, rr = rsqrtf(q);
        if ((lane & 0x37) == 0) RINV[r + sub] = q * rr;
        bf16_t* hb = HN + (size_t)(r >> 4) * 16384 + (r & 15) * 32 + (lane >> 4) * 512 + (lane & 15) * 4;
#pragma unroll
        for (int j = 0; j < 8; ++j) {
            u32x2 o; o.x = cvt_pk_bf16(v[j].x * rr * gv[j].x, v[j].y * rr * gv[j].y); o.y = cvt_pk_bf16(v[j].z * rr * gv[j].z, v[j].w * rr * gv[j].w);
            *(u32x2*)(hb + j * 2048) = o;
        }
#pragma unroll
        for (int j = 0; j < 8; ++j) v[j] = nx[j];
    }
}

__device__ __forceinline__ f32x16 mfma32(bf16x8 a, bf16x8 b, f32x16 c) { return __builtin_amdgcn_mfma_f32_32x32x16_bf16(a, b, c, 0, 0, 0); }
__device__ __forceinline__ void phase_ssm(const Args& a, const Ctx& c, unsigned char* ldsg) {
    const int tid = threadIdx.x, lane = tid & 63, wave = __builtin_amdgcn_readfirstlane(tid >> 6);
    unsigned char* ws = a.ws;
    const bf16_t* lw = (const bf16_t*)ldsg;
    float2* shE = (float2*)(ldsg + 139776);
    const bf16_t* U3 = (const bf16_t*)(c.wsg + G_U3);
    bf16_t* YG = (bf16_t*)(c.wsg + G_YG);
    const float4* TSC = (const float4*)(ws + WS_TSC);
    const int boff = (lane >> 5) * 256 + (lane & 31) * 8;
    const int koff = (lane >> 5) * KT_PLANE + (lane & 31) * 8;
    for (int item = c.vb; item < 128; item += c.GV) {
        const int b = item >> 5, g = item & 31;
        {
            const u32x4* s0 = (const u32x4*)(ws + WS_TWST + (size_t)g * 65536); u32x4* d0 = (u32x4*)ldsg;
            const u32x4* s1 = (const u32x4*)(ws + WS_TWOUT + (size_t)g * 65536); u32x4* d1 = (u32x4*)(ldsg + 65536);
            const u32x4* s2 = (const u32x4*)(ws + WS_TKT + (size_t)g * (KT_ELEMS * 2)); u32x4* d2 = (u32x4*)(ldsg + 131072);
#pragma unroll
            for (int i = 0; i < 8; ++i) { d0[tid + 512 * i] = s0[tid + 512 * i]; d1[tid + 512 * i] = s1[tid + 512 * i]; }
            for (int i = tid; i < (KT_ELEMS * 2) / 16; i += 512) d2[i] = s2[i];
        }
        __syncthreads();
        const bf16_t* Ubg = U3 + (size_t)item * 131072;
        const bf16_t* Ul = Ubg + (lane & 31) * 256 + (lane >> 5) * 8;
        float* Sw = (float*)(c.wsg + G_SWS) + (size_t)item * 65536;
        bf16_t* Cw = (bf16_t*)(c.wsg + G_CWS) + (size_t)item * 65536;
        for (int q = 0; q < 2; ++q) {
            const int mb = wave * 2 + q;
            bf16x8 ua[16];
#pragma unroll
            for (int s = 0; s < 16; ++s) ua[s] = *(const bf16x8*)(Ul + mb * 8192 + s * 16);
#pragma unroll 1
            for (int nb = 0; nb < 4; ++nb) {
                f32x16 acc;
#pragma unroll
                for (int r = 0; r < 16; ++r) acc[r] = 0.f;
#pragma unroll
                for (int s = 0; s < 16; ++s) { const bf16x8 B = *(const bf16x8*)(lw + (s * 4 + nb) * 512 + boff); acc = mfma32(ua[s], B, acc); }
#pragma unroll
                for (int r = 0; r < 16; ++r) { const int row = (r & 3) + 8 * (r >> 2) + 4 * (lane >> 5); Sw[(size_t)(mb * 32 + row) * 128 + nb * 32 + (lane & 31)] = acc[r]; }
            }
        }
        __builtin_amdgcn_fence(__ATOMIC_RELEASE, "workgroup"); asm volatile("s_waitcnt vmcnt(0)" ::: "memory"); __builtin_amdgcn_fence(__ATOMIC_ACQUIRE, "workgroup");
        {
            const float4 sc = TSC[g * 64 + lane];
            const float* Sp = Sw + (size_t)(wave * 64) * 128 + lane;
            float sr[32], si[32];
            float xr = 0.f, xi = 0.f;
#pragma unroll 1
            for (int hb = 0; hb < 2; ++hb) {
#pragma unroll
                for (int n = 0; n < 32; ++n) { sr[n] = Sp[(hb * 32 + n) * 128]; si[n] = Sp[(hb * 32 + n) * 128 + 64]; }
#pragma unroll
                for (int n = 0; n < 32; ++n) { const float nr = sc.x * xr - sc.y * xi + sr[n], ni = sc.x * xi + sc.y * xr + si[n]; xr = nr; xi = ni; }
            }
            shE[wave * 64 + lane] = make_float2(xr, xi);
            __syncthreads();
            xr = 0.f; xi = 0.f;
            for (int v = 0; v < wave; ++v) { const float2 e = shE[v * 64 + lane]; const float nr = sc.z * xr - sc.w * xi + e.x, ni = sc.z * xi + sc.w * xr + e.y; xr = nr; xi = ni; }
            bf16_t* Cp = Cw + (size_t)(wave * 64) * 128 + lane;
#pragma unroll 1
            for (int hb = 0; hb < 2; ++hb) {
#pragma unroll
                for (int n = 0; n < 32; ++n) { sr[n] = Sp[(hb * 32 + n) * 128]; si[n] = Sp[(hb * 32 + n) * 128 + 64]; }
#pragma unroll
                for (int n = 0; n < 32; ++n) {
                    Cp[(hb * 32 + n) * 128] = f2bf(xr); Cp[(hb * 32 + n) * 128 + 64] = f2bf(xi);
                    const float nr = sc.x * xr - sc.y * xi + sr[n], ni = sc.x * xi + sc.y * xr + si[n]; xr = nr; xi = ni;
                }
            }
        }
        __builtin_amdgcn_fence(__ATOMIC_RELEASE, "workgroup"); asm volatile("s_waitcnt vmcnt(0)" ::: "memory"); __builtin_amdgcn_fence(__ATOMIC_ACQUIRE, "workgroup");
        for (int q = 0; q < 2; ++q) {
            const int mb = wave * 2 + q;
            bf16x8 ua[16], ca[8];
#pragma unroll
            for (int s = 0; s < 16; ++s) ua[s] = *(const bf16x8*)(Ul + mb * 8192 + s * 16);
#pragma unroll
            for (int kk = 0; kk < 8; ++kk) ca[kk] = *(const bf16x8*)(Cw + (size_t)(mb * 32 + (lane & 31)) * 128 + kk * 16 + (lane >> 5) * 8);
#pragma unroll 1
            for (int ni = 0; ni < 8; ++ni) {
                f32x16 acc;
#pragma unroll
                for (int r = 0; r < 16; ++r) acc[r] = 0.f;
#pragma unroll
                for (int s = 0; s < 16; ++s) if (s <= 2 * ni + 1) { const bf16x8 B = *(const bf16x8*)(lw + 65536 + (2 * ni - s + 1) * 128 + koff); acc = mfma32(ua[s], B, acc); }
#pragma unroll
                for (int kk = 0; kk < 8; ++kk) { const bf16x8 B = *(const bf16x8*)(lw + 32768 + (kk * 8 + ni) * 512 + boff); acc = mfma32(ca[kk], B, acc); }
                const int tau = 2 * ni + ((lane & 31) >> 4), hp = lane & 15;
#pragma unroll
                for (int r = 0; r < 16; ++r) {
                    const int row = (r & 3) + 8 * (r >> 2) + 4 * (lane >> 5);
                    const int tl = (mb * 32 + row) * 16 + tau;
                    YG[((size_t)(b * SEQ + tl)) * 512 + g * 16 + hp] = f2bf(gelu_tanh(acc[r]));
                }
            }
        }
        __syncthreads();
    }
}

__device__ __forceinline__ void unpack8(const u32x4 w, float (&f)[8]) { f[0] = bf_lo(w.x); f[1] = bf_hi(w.x); f[2] = bf_lo(w.y); f[3] = bf_hi(w.y); f[4] = bf_lo(w.z); f[5] = bf_hi(w.z); f[6] = bf_lo(w.w); f[7] = bf_hi(w.w); }
__device__ __forceinline__ u32x4 pack8(const float (&f)[8]) { u32x4 w; w.x = cvt_pk_bf16(f[0], f[1]); w.y = cvt_pk_bf16(f[2], f[3]); w.z = cvt_pk_bf16(f[4], f[5]); w.w = cvt_pk_bf16(f[6], f[7]); return w; }
__device__ __forceinline__ void phase_mix(const Args& a, const Ctx& c) {
    const int tid = threadIdx.x, lane = tid & 63, wave = tid >> 6;
    const int gw = c.vb * 8 + wave, NGW = c.GV * 8;
    const bf16_t* P = (const bf16_t*)(c.wsg + G_PROJ); bf16_t* YCAT = (bf16_t*)(c.wsg + G_YCAT); const float* SS = (const float*)(a.ws + WS_SS) + (size_t)c.grp * M_HALF;
    const float* cw = a.in[12]; const float* gc = a.in[14];
    const int j0 = 8 * lane;
    float w0[8], w1[8], w2[8], gcv[8];
#pragma unroll
    for (int j = 0; j < 8; ++j) { w0[j] = cw[j0 + j]; w1[j] = cw[512 + j0 + j]; w2[j] = cw[1024 + j0 + j]; gcv[j] = gc[j0 + j]; }
    constexpr int STRIP = 32;
    for (int st = gw; st < M_HALF / STRIP; st += NGW) {
        const int row0 = st * STRIP;
        float zp2[8], zp1[8];
        if ((row0 & (SEQ - 1)) == 0) {
#pragma unroll
            for (int j = 0; j < 8; ++j) { zp2[j] = 0.f; zp1[j] = 0.f; }
        } else {
            unpack8(*(const u32x4*)(P + (size_t)(row0 - 2) * 1024 + j0), zp2);
            unpack8(*(const u32x4*)(P + (size_t)(row0 - 1) * 1024 + j0), zp1);
        }
        constexpr int PR = 4;
        u32x4 lz[PR], lb[PR], nz[PR], nb[PR]; float ly[PR], ny[PR];
#pragma unroll
        for (int k = 0; k < PR; ++k) { const size_t r = (size_t)(row0 + k); lz[k] = *(const u32x4*)(P + r * 1024 + j0); lb[k] = *(const u32x4*)(P + r * 1024 + 512 + j0); ly[k] = SS[r]; }
        for (int i = 0; i < STRIP; i += PR) {
            if (i + PR < STRIP) {
#pragma unroll
                for (int k = 0; k < PR; ++k) { const size_t r = (size_t)(row0 + i + PR + k); nz[k] = *(const u32x4*)(P + r * 1024 + j0); nb[k] = *(const u32x4*)(P + r * 1024 + 512 + j0); ny[k] = SS[r]; }
            }
#pragma unroll
            for (int k = 0; k < PR; ++k) {
                const int row = row0 + i + k;
                float bg[8], z[8], yc[8];
                unpack8(lz[k], z); unpack8(lb[k], bg);
                float ssc = 0.f;
#pragma unroll
                for (int j = 0; j < 8; ++j) { yc[j] = bg[j] * (w0[j] * zp2[j] + w1[j] * zp1[j] + w2[j] * z[j]); ssc += yc[j] * yc[j]; }
                ssc = wave_sum(ssc);
                const float rc = rsqrtf(ssc * (1.f / 512.f) + RMS_EPS) * sqrtf(ly[k] * (1.f / 512.f) + RMS_EPS);
#pragma unroll
                for (int j = 0; j < 8; ++j) { yc[j] = yc[j] * rc * gcv[j]; zp2[j] = zp1[j]; zp1[j] = z[j]; }
                *(u32x4*)(YCAT + (size_t)row * 1024 + 512 + j0) = pack8(yc);
            }
#pragma unroll
            for (int k = 0; k < PR; ++k) { lz[k] = nz[k]; lb[k] = nb[k]; ly[k] = ny[k]; }
        }
    }
}

__device__ __forceinline__ void phase_resid6(const Args& a, const Ctx& c) {
    const int tid = threadIdx.x, lane = tid & 63, wave = tid >> 6;
    const int gw = c.vb * 8 + wave, NGW = c.GV * 8;
    const bf16_t* HN = (const bf16_t*)(c.wsg + G_HN); const float* RINV = (const float*)(a.ws + WS_RINV) + (size_t)c.grp * M_HALF;
    const bf16_t* O = (const bf16_t*)(c.wsg + G_O); bf16_t* X1B = (bf16_t*)(c.wsg + G_X1B);
    const float* SS = (const float*)(a.ws + WS_SS) + (size_t)c.grp * M_HALF;
    const int sub = (lane >> 3) & 1, cl = 32 * (lane >> 4) + 4 * (lane & 7), lo = (lane >> 4) * 512 + (lane & 15) * 4;
    f32x4 g1[8], gi[8];
#pragma unroll
    for (int j = 0; j < 8; ++j) { g1[j] = *(const f32x4*)(a.in[16] + cl + 128 * j); const f32x4 g0 = *(const f32x4*)(a.in[1] + cl + 128 * j); gi[j] = (f32x4){1.f / g0.x, 1.f / g0.y, 1.f / g0.z, 1.f / g0.w}; }
    u32x2 xv[8], nxv[8], ov[8], nov[8]; float ssv, nssv = 0.f, riv, nriv = 0.f;
    { const int r = 2 * gw; const size_t bo = (size_t)(r >> 4) * 16384 + (r & 15) * 32 + lo; ssv = SS[r + sub]; riv = RINV[r + sub];
#pragma unroll
      for (int j = 0; j < 8; ++j) { xv[j] = *(const u32x2*)(HN + bo + j * 2048); ov[j] = *(const u32x2*)(O + bo + j * 2048); } }
    for (int pr = gw; pr < M_HALF / 2; pr += NGW) {
        const int pn = pr + NGW, r = 2 * pr;
        if (pn < M_HALF / 2) { const int rn = 2 * pn; const size_t bo = (size_t)(rn >> 4) * 16384 + (rn & 15) * 32 + lo; nssv = SS[rn + sub]; nriv = RINV[rn + sub];
#pragma unroll
            for (int j = 0; j < 8; ++j) { nxv[j] = *(const u32x2*)(HN + bo + j * 2048); nov[j] = *(const u32x2*)(O + bo + j * 2048); } }
        f32x4 of[8]; float so = 0.f;
#pragma unroll
        for (int j = 0; j < 8; ++j) { of[j] = (f32x4){bf_lo(ov[j].x), bf_hi(ov[j].x), bf_lo(ov[j].y), bf_hi(ov[j].y)}; so += (of[j].x * of[j].x + of[j].y * of[j].y) + (of[j].z * of[j].z + of[j].w * of[j].w); }
        const float ro = rsqrtf(pair_sum(so) * (1.f / DM) + RMS_EPS * (ssv * (1.f / 512.f) + RMS_EPS));
        bf16_t* xb = X1B + (size_t)(r >> 4) * 16384 + (r & 15) * 32 + lo;
#pragma unroll
        for (int j = 0; j < 8; ++j) {
            const f32x4 xr = (f32x4){bf_lo(xv[j].x), bf_hi(xv[j].x), bf_lo(xv[j].y), bf_hi(xv[j].y)} * gi[j] * riv;
            const f32x4 x1 = xr + of[j] * ro * g1[j];
            u32x2 q; q.x = cvt_pk_bf16(x1.x, x1.y); q.y = cvt_pk_bf16(x1.z, x1.w); *(u32x2*)(xb + j * 2048) = q;
        }
#pragma unroll
        for (int j = 0; j < 8; ++j) { xv[j] = nxv[j]; ov[j] = nov[j]; }
        ssv = nssv; riv = nriv;
    }
}
__device__ __forceinline__ void phase_final(const Args& a, const Ctx& c) {
    const int tid = threadIdx.x, lane = tid & 63, wave = tid >> 6;
    const int gw = c.vb * 8 + wave, NGW = c.GV * 8;
    float* outp = a.out + (size_t)c.m0 * DM;
    const bf16_t* MO = (const bf16_t*)(c.wsg + G_HN); const bf16_t* X1B = (const bf16_t*)(c.wsg + G_X1B);
    const int sub = (lane >> 3) & 1, cl = 32 * (lane >> 4) + 4 * (lane & 7), lo = (lane >> 4) * 512 + (lane & 15) * 4;
    f32x4 g2[8];
#pragma unroll
    for (int j = 0; j < 8; ++j) g2[j] = *(const f32x4*)(a.in[20] + cl + 128 * j);
    u32x2 xv[8], nxv[8], mv[8], nmv[8];
    { const int r = 2 * gw; const size_t bo = (size_t)(r >> 4) * 16384 + (r & 15) * 32 + lo;
#pragma unroll
      for (int j = 0; j < 8; ++j) { xv[j] = *(const u32x2*)(X1B + bo + j * 2048); mv[j] = *(const u32x2*)(MO + bo + j * 2048); } }
    for (int pr = gw; pr < M_HALF / 2; pr += NGW) {
        const int pn = pr + NGW, r = 2 * pr;
        if (pn < M_HALF / 2) { const int rn = 2 * pn; const size_t bo = (size_t)(rn >> 4) * 16384 + (rn & 15) * 32 + lo;
#pragma unroll
            for (int j = 0; j < 8; ++j) { nxv[j] = *(const u32x2*)(X1B + bo + j * 2048); nmv[j] = *(const u32x2*)(MO + bo + j * 2048); } }
        f32x4 mf[8], x1[8]; float sm = 0.f, s1 = 0.f;
#pragma unroll
        for (int j = 0; j < 8; ++j) { mf[j] = (f32x4){bf_lo(mv[j].x), bf_hi(mv[j].x), bf_lo(mv[j].y), bf_hi(mv[j].y)};
            x1[j] = (f32x4){bf_lo(xv[j].x), bf_hi(xv[j].x), bf_lo(xv[j].y), bf_hi(xv[j].y)};
            sm += (mf[j].x * mf[j].x + mf[j].y * mf[j].y) + (mf[j].z * mf[j].z + mf[j].w * mf[j].w);
            s1 += (x1[j].x * x1[j].x + x1[j].y * x1[j].y) + (x1[j].z * x1[j].z + x1[j].w * x1[j].w); }
        sm = pair_sum(sm); s1 = pair_sum(s1);
        const float q1 = s1 * (1.f / DM) + RMS_EPS;
        const float rm = rsqrtf(sm * (1.f / DM) + RMS_EPS * q1 * q1);
        float* ob = outp + (size_t)(r + sub) * DM + cl;
#pragma unroll
        for (int j = 0; j < 8; ++j) __builtin_nontemporal_store(x1[j] + mf[j] * rm * g2[j], (f32x4*)(ob + 128 * j));
#pragma unroll
        for (int j = 0; j < 8; ++j) { xv[j] = nxv[j]; mv[j] = nmv[j]; }
    }
}

template <class Epi, bool ABLK = false> __device__ __forceinline__ void run_gemm(unsigned char* lds, const Ctx& c, const bf16_t* A, const bf16_t* Bt, int N, int K, const Epi& E, int rev = 0) {
    pg8::StaticOrder S; S.init(M_HALF, N, c.GV, c.vb, 4, rev);
    pg8::gemm_phase<Epi, pg8::StaticOrder, true, true, ABLK>((PG8_LAS unsigned char*)lds, pg8::Gemm{A, Bt, M_HALF, N, K}, S, E);
}
#ifdef PROBE_DUMMY
struct ProbeOrder : pg8::StaticOrder {
    int mode;
    __device__ bool next(int i, pg8::Unit& u) const { if (mode) { if (i >= 16) return false; u.pm = 0; u.pn = 0; return true; } return pg8::StaticOrder::next(i, u); }
};
#endif
__global__ void __launch_bounds__(512, 2) hymba_fwd(Args a) {
    extern __shared__ __attribute__((aligned(16))) unsigned char lds[];
    Ctx c;
    c.GV = (int)gridDim.x >> 1; c.grp = ((int)blockIdx.x & 7) >> 2; c.vb = (((int)blockIdx.x >> 3) << 2) | ((int)blockIdx.x & 3);
    c.m0 = c.grp * M_HALF; c.wsg = a.ws + WS_GROUP0 + (size_t)c.grp * GROUP_BYTES;
    unsigned char* ws = a.ws; unsigned char* wsg = c.wsg;
    volatile LAS unsigned* st = (volatile LAS unsigned*)((LAS unsigned char*)lds + LDS_ST_OFF);
    if (threadIdx.x < 4) st[threadIdx.x] = 0u;
    __syncthreads();
    const XcdBarrier gb = xcd_barrier_post((unsigned*)(ws + WS_BAR + (size_t)c.grp * BAR_STRIDE), st, (unsigned)c.GV);
    unsigned* wready = (unsigned*)(ws + WS_BAR + 2 * BAR_STRIDE);
    if (a.ph_lo < 0) cg::this_grid().sync();
    if (c.grp == 1) {
        phase_prep_w(a, c, lds);
#if defined(PROBE_X2) && (PROBE_X2 & 1)
        __syncthreads(); phase_prep_w(a, c, lds);
#endif
        asm volatile("s_waitcnt vmcnt(0)" ::: "memory");
        __syncthreads();
        if (threadIdx.x == 0) {
            __builtin_amdgcn_fence(__ATOMIC_RELEASE, "agent");
            asm volatile("s_waitcnt vmcnt(0)" ::: "memory");
            (void)__hip_atomic_fetch_add(wready, 1u, __ATOMIC_RELAXED, __HIP_MEMORY_SCOPE_AGENT);
        }
        phase_xnorm(a, c);
    } else {
        phase_xnorm(a, c);
        if (threadIdx.x == 0) {
            unsigned sp = 0;
            while (__hip_atomic_load(wready, __ATOMIC_RELAXED, __HIP_MEMORY_SCOPE_AGENT) < (unsigned)c.GV) { __builtin_amdgcn_s_sleep(2); if (++sp > (1u << 22)) break; }
            __builtin_amdgcn_fence(__ATOMIC_ACQUIRE, "agent");
            asm volatile("s_waitcnt vmcnt(0)" ::: "memory");
        }
        __syncthreads();
    }
    xcd_barrier(gb);
    run_gemm<EpiProj, true>(lds, c, (const bf16_t*)(wsg + G_HN), (const bf16_t*)(ws + WS_WIN), 2048, 1024, EpiProj{(bf16_t*)(wsg + G_U3), (bf16_t*)(wsg + G_PROJ)});
    xcd_barrier(gb);
    phase_ssm(a, c, lds);
    xcd_barrier(gb);
    run_gemm(lds, c, (const bf16_t*)(wsg + G_YG), (const bf16_t*)(ws + WS_WGLU), 512, 512, EpiGlu{(const bf16_t*)(wsg + G_YG), (bf16_t*)(wsg + G_YCAT), a.in[13], (float*)(ws + WS_SS) + (size_t)c.grp * M_HALF});
    xcd_barrier(gb);
    phase_mix(a, c);
#if defined(PROBE_X2) && (PROBE_X2 & 2)
    if (c.grp == 1) phase_mix(a, c);
#endif
    xcd_barrier(gb);
    run_gemm(lds, c, (const bf16_t*)(wsg + G_YCAT), (const bf16_t*)(ws + WS_WOUT), 1024, 1024, EpiStoreBlk<0>{(bf16_t*)(wsg + G_O), 1024});
    xcd_barrier(gb);
    phase_resid6(a, c);
#if defined(PROBE_X2) && (PROBE_X2 & 2)
    if (c.grp == 1) phase_resid6(a, c);
#endif
    xcd_barrier(gb);
#ifdef PROBE_DUMMY
#pragma unroll 1
    for (int rp = 0; rp < 2; ++rp) {
        ProbeOrder S; S.init(M_HALF, 4096, c.GV, c.vb, 4); S.mode = rp;
        EpiStore<1> E{rp ? (bf16_t*)(ws + WS_END) : (bf16_t*)(wsg + G_H), 4096};
        pg8::gemm_phase<EpiStore<1>, ProbeOrder, true, true>((PG8_LAS unsigned char*)lds, pg8::Gemm{(const bf16_t*)(wsg + G_X1B), (const bf16_t*)(ws + WS_WUP), M_HALF, 4096, 1024}, S, E);
        xcd_barrier(gb);
    }
#elif defined(PROBE_UP2)
#pragma unroll 1
    for (int rp = 0; rp < (c.grp == 1 ? 2 : 1); ++rp) {
        run_gemm(lds, c, (const bf16_t*)(wsg + G_X1B), (const bf16_t*)(ws + WS_WUP), 4096, 1024, EpiStore<1>{(bf16_t*)(wsg + G_H), 4096});
        xcd_barrier(gb);
    }
#else
    run_gemm<EpiStoreBlk<1>, true>(lds, c, (const bf16_t*)(wsg + G_X1B), (const bf16_t*)(ws + WS_WUP), 4096, 1024, EpiStoreBlk<1>{(bf16_t*)(wsg + G_H), 4096});
    xcd_barrier(gb);
#endif
    run_gemm<EpiStoreBlk<0>, true>(lds, c, (const bf16_t*)(wsg + G_H), (const bf16_t*)(ws + WS_WDN), 1024, 4096, EpiStoreBlk<0>{(bf16_t*)(wsg + G_HN), 1024}, 1);
    xcd_barrier(gb);
    phase_final(a, c);
#if defined(PROBE_X2) && (PROBE_X2 & 2)
    if (c.grp == 1) phase_final(a, c);
#endif
}

extern "C" void kernel_launch(void* const* d_in, const int* in_sizes, int n_in, void* d_out, int out_size, void* d_ws, size_t ws_size, hipStream_t stream) {
    static int grid = 0;
    if (grid == 0) {
        if (n_in != 21 || in_sizes[0] != M_TOK * DM || out_size != M_TOK * DM || ws_size < WS_END) {
            fprintf(stderr, "kernel_launch: unexpected shapes (n_in %d, in0 %d, out %d, ws %zu < %zu)\n", n_in, n_in > 0 ? in_sizes[0] : -1, out_size, ws_size, (size_t)WS_END); grid = -1; return; }
        int dev = 0, cus = 0, per_cu = 0;
        (void)hipGetDevice(&dev); (void)hipDeviceGetAttribute(&cus, hipDeviceAttributeMultiprocessorCount, dev);
        if (hipFuncSetAttribute((const void*)hymba_fwd, hipFuncAttributeMaxDynamicSharedMemorySize, LDS_BYTES) != hipSuccess) fprintf(stderr, "kernel_launch: hipFuncSetAttribute failed\n");
        if (hipOccupancyMaxActiveBlocksPerMultiprocessor(&per_cu, (const void*)hymba_fwd, 512, LDS_BYTES) != hipSuccess || per_cu < 1) { fprintf(stderr, "kernel_launch: occupancy query says %d\n", per_cu); per_cu = 1; }
        (void)hipGetLastError();
        grid = cus * per_cu;
        if (grid > 256) grid = 256;
        grid &= ~15;
        if (grid < 16) { fprintf(stderr, "kernel_launch: grid %d too small\n", grid); grid = -1; return; }
    }
    if (grid < 0) return;
    Args a{};
    for (int i = 0; i < 21; ++i) a.in[i] = (const float*)d_in[i];
    a.out = (float*)d_out; a.ws = (unsigned char*)d_ws;
    a.ph_lo = 0; a.ph_hi = N_PHASES;
    if (hipMemsetAsync((unsigned char*)d_ws + WS_BAR, 0, BAR_BYTES, stream) != hipSuccess) { fprintf(stderr, "kernel_launch: memset of the barrier words failed\n"); return; }
    void* args[] = {&a};
    hipError_t e = hipLaunchCooperativeKernel((const void*)hymba_fwd, dim3(grid), dim3(512), args, LDS_BYTES, stream);
    if (e != hipSuccess) fprintf(stderr, "kernel_launch: cooperative launch failed: %s (grid %d)\n", hipGetErrorString(e), grid);
}
```

```cpp
#define MK_MULTI 0
#include <hip/hip_runtime.h>
namespace pg8 {
#define PG8_LAS __attribute__((address_space(3)))
typedef unsigned short bf16_t;
typedef short bf16x8 __attribute__((ext_vector_type(8)));
typedef float f32x4 __attribute__((ext_vector_type(4)));
typedef unsigned u32x4 __attribute__((ext_vector_type(4)));
constexpr int BM = 256, BK = 64, HALF = 128, HTB = HALF * BK * 2  , STAGE_BYTES = 8 * HTB, NXCD = 8, WGM = 8;

__host__ __device__ __forceinline__ int lds_byte(int r, int c) { const int st = (r >> 4) * 2 + (c >> 5), rr = r & 15, cc = c & 31, ob = rr * 64 + cc * 2; return st * 1024 + (ob ^ (((ob >> 9) & 1) << 5)); }
__host__ __device__ __forceinline__ void stage_rc(int b, int& R, int& C) { const int st = b / 1024, sb = b % 1024, swz = sb ^ (((sb >> 9) & 1) << 5); R = (st >> 1) * 16 + swz / 64; C = (st & 1) * 32 + (swz % 64) / 2; }
__host__ __device__ __forceinline__ int perm32(int rho) { const int n = rho >> 4, i = rho & 15; return 8 * (i >> 2) + 4 * n + (i & 3); }

struct Unit { int pm, pn; };
struct Gemm { const bf16_t* A; const bf16_t* Bt; int M, N, K; };

struct StaticOrder {
    int nM, nN, nwg, G, c, nx, rev;
    __host__ __device__ void init(int M, int N, int G_, int c_, int nx_ = NXCD, int rev_ = 0) { nM = M / BM; nN = N / BM; nwg = nM * nN; G = G_; c = c_; nx = nx_; rev = (rev_ && nwg % G_ == 0) ? 1 : 0; }
    __host__ __device__ bool next(int i, Unit& u) const {
        const long L = (long)(rev ? (nwg / G - 1 - i) : i) * G + c; if (L >= nwg || L < 0) return false;
        int wgid = (int)L; { const int q = nwg / nx, r = nwg % nx, xcd = wgid % nx, off = wgid / nx; wgid = (xcd < r ? xcd * (q + 1) : r * (q + 1) + (xcd - r) * q) + off; }
        const int nig = WGM * nN, gid = wgid / nig, fm = gid * WGM, gsz = (nM - fm) < WGM ? (nM - fm) : WGM;
        u.pm = fm + ((wgid % nig) % gsz); u.pn = (wgid % nig) / gsz; return true;
    }
    __device__ __forceinline__ void a_ready(const Unit&) const {}
    __device__ __forceinline__ void done(const Unit&) const {}
};
__device__ __forceinline__ unsigned cvt_pk_bf16(float lo, float hi) { unsigned r; asm("v_cvt_pk_bf16_f32 %0, %1, %2" : "=v"(r) : "v"(lo), "v"(hi)); return r; }
template <class Epi, class Sched, bool ALIGN_EPI = false, bool SP2 = false, bool ABLK = false>
__device__ __forceinline__ void gemm_phase(PG8_LAS unsigned char* lds, const Gemm g, const Sched& S, const Epi& E) {
    const int tid = threadIdx.x, wid = __builtin_amdgcn_readfirstlane(tid >> 6), lane = tid & 63, wr = wid >> 2, wc = wid & 3, fr = lane & 15, fq = lane >> 4;
    const int K = g.K, nt = K / BK;
    unsigned voffA[2], voffB[2];
#pragma unroll
    for (int i = 0; i < 2; ++i) { int R, C; stage_rc(tid * 16 + i * 8192, R, C); const int Rb = Epi::PERM ? ((R & ~31) + perm32(R & 31)) : R;
        voffA[i] = ABLK ? (unsigned)(((((R >> 4) * (K >> 5) + (C >> 5)) * 16 + (R & 15)) * 32 + (C & 31))) * 2u : (unsigned)(R * K + C) * 2u; voffB[i] = (unsigned)(Rb * K + C) * 2u; }
    const size_t kstep = (size_t)(BK * 2);
    const size_t kstepA = ABLK ? (size_t)2048 : kstep;
    const size_t hstep = (size_t)HALF * K * 2;
    const size_t tstep = 2 * hstep;
    const unsigned ldsw = (unsigned)wid * 1024u;
    const int aoff = lds_byte(wr * 64 + fr, fq * 8), boff = lds_byte(wc * 32 + fr, fq * 8);
#define PG8_SA(b, h) (((b) * 2 + (h)) * HTB)
#define PG8_SB(b, h) ((4 + (b) * 2 + (h)) * HTB)
#define PG8_STAGE(bufoff, gbase, voff) do { _Pragma("unroll") for (int _i = 0; _i < 2; ++_i) \
        __builtin_amdgcn_global_load_lds((const unsigned*)((const char*)(gbase) + (voff)[_i]), (PG8_LAS unsigned*)(lds + (bufoff) + ldsw + _i * 8192), 16, 0, 0); } while (0)
#define PG8_LDA(dst, b, h) do { _Pragma("unroll") for (int m = 0; m < 4; ++m) _Pragma("unroll") for (int k = 0; k < 2; ++k) dst[m][k] = *(const PG8_LAS bf16x8*)(lds + PG8_SA(b, h) + aoff + m * 2048 + k * 1024); } while (0)
#define PG8_LDB(dst, b, h) do { _Pragma("unroll") for (int n = 0; n < 2; ++n) _Pragma("unroll") for (int k = 0; k < 2; ++k) dst[n][k] = *(const PG8_LAS bf16x8*)(lds + PG8_SB(b, h) + boff + n * 2048 + k * 1024); } while (0)
#define PG8_MMA(ai, bj, At, Bt) do { __builtin_amdgcn_s_setprio(1); _Pragma("unroll") for (int m = 0; m < 4; ++m) _Pragma("unroll") for (int n = 0; n < 2; ++n) _Pragma("unroll") for (int k = 0; k < 2; ++k) \
        acc[ai][bj][m][n] = __builtin_amdgcn_mfma_f32_16x16x32_bf16(Bt[n][k], At[m][k], acc[ai][bj][m][n], 0, 0, 0); __builtin_amdgcn_s_setprio(0); } while (0)
#define PG8_MMAQ(ai, bj, At, Bt) do { _Pragma("unroll") for (int m = 0; m < 4; ++m) _Pragma("unroll") for (int n = 0; n < 2; ++n) _Pragma("unroll") for (int k = 0; k < 2; ++k) \
        acc[ai][bj][m][n] = __builtin_amdgcn_mfma_f32_16x16x32_bf16(Bt[n][k], At[m][k], acc[ai][bj][m][n], 0, 0, 0); } while (0)
#define PG8_WAIT_V(n) asm volatile("s_waitcnt vmcnt(" #n ")" ::: "memory")
#define PG8_WAIT_L(n) asm volatile("s_waitcnt lgkmcnt(" #n ")" ::: "memory")
#define PG8_BAR __builtin_amdgcn_s_barrier()
#define PG8_SCHED __builtin_amdgcn_sched_barrier(0)
    Unit cur, nxt; int ui = 0;
    if (!S.next(0, cur)) return;
    f32x4 acc[2][2][4][2];
#pragma unroll
    for (int a = 0; a < 2; ++a)
#pragma unroll
        for (int b = 0; b < 2; ++b)
#pragma unroll
            for (int m = 0; m < 4; ++m)
#pragma unroll
                for (int n = 0; n < 2; ++n) acc[a][b][m][n] = (f32x4){0.f, 0.f, 0.f, 0.f};
    bf16x8 At[4][2], B0[2][2], B1[2][2];
    const char* cA = (const char*)g.A + (size_t)cur.pm * tstep; const char* cB = (const char*)g.Bt + (size_t)cur.pn * tstep;
    S.a_ready(cur);
    if constexpr (SP2) {
        PG8_STAGE(PG8_SB(0, 0), cB, voffB); PG8_STAGE(PG8_SB(0, 1), cB + hstep, voffB); PG8_STAGE(PG8_SA(0, 0), cA, voffA); PG8_STAGE(PG8_SA(0, 1), cA + hstep, voffA);
        if (wr == 1) PG8_BAR;
        PG8_WAIT_V(2); PG8_BAR;
        PG8_STAGE(PG8_SB(1, 0), cB + kstep, voffB); PG8_STAGE(PG8_SA(1, 0), cA + kstepA, voffA); PG8_STAGE(PG8_SB(1, 1), cB + hstep + kstep, voffB);
        PG8_WAIT_V(6); PG8_BAR;
    } else {
        PG8_STAGE(PG8_SB(0, 0), cB, voffB); PG8_STAGE(PG8_SA(0, 0), cA, voffA); PG8_STAGE(PG8_SB(0, 1), cB + hstep, voffB); PG8_STAGE(PG8_SA(0, 1), cA + hstep, voffA);
        if (wr == 1) PG8_BAR;
        PG8_WAIT_V(4); PG8_BAR;
        PG8_STAGE(PG8_SB(1, 0), cB + kstep, voffB); PG8_STAGE(PG8_SA(1, 0), cA + kstepA, voffA); PG8_STAGE(PG8_SB(1, 1), cB + hstep + kstep, voffB);
        PG8_WAIT_V(6); PG8_BAR;
    }
    for (;;) {
        const bool has_next = S.next(ui + 1, nxt);
        const char* nA = has_next ? (const char*)g.A + (size_t)nxt.pm * tstep : cA; const char* nB = has_next ? (const char*)g.Bt + (size_t)nxt.pn * tstep : cB;
        for (int t = 0; t < nt; t += 2) {
            const bool last = (t == nt - 2);
            const char* a1 = cA + (size_t)(t + 1) * kstepA;
            const char* a2 = last ? nA : cA + (size_t)(t + 2) * kstepA; const char* b2 = last ? nB : cB + (size_t)(t + 2) * kstep;
            const char* a3 = a2 + kstepA; const char* b3 = b2 + kstep;
            if (last && has_next) S.a_ready(nxt);
            if constexpr (SP2) {
            PG8_LDB(B0, 0, 0); PG8_LDB(B1, 0, 1); PG8_SCHED; PG8_LDA(At, 0, 0); PG8_STAGE(PG8_SA(1, 1), a1 + hstep, voffA);
            PG8_WAIT_V(8); PG8_WAIT_L(0); PG8_BAR; __builtin_amdgcn_s_setprio(1); PG8_MMAQ(0, 0, At, B0); PG8_MMAQ(0, 1, At, B1); __builtin_amdgcn_s_setprio(0); PG8_BAR; PG8_SCHED;
            PG8_LDA(At, 0, 1); PG8_STAGE(PG8_SB(0, 0), b2, voffB); PG8_STAGE(PG8_SB(0, 1), b2 + hstep, voffB); PG8_STAGE(PG8_SA(0, 0), a2, voffA);
            PG8_WAIT_V(8); PG8_WAIT_L(0); PG8_BAR; __builtin_amdgcn_s_setprio(1); PG8_MMAQ(1, 0, At, B0); PG8_MMAQ(1, 1, At, B1); __builtin_amdgcn_s_setprio(0); PG8_BAR; PG8_SCHED;
            PG8_LDB(B0, 1, 0); PG8_LDB(B1, 1, 1); PG8_SCHED; PG8_LDA(At, 1, 0); PG8_STAGE(PG8_SA(0, 1), a2 + hstep, voffA);
            PG8_WAIT_V(8); PG8_WAIT_L(0); PG8_BAR; __builtin_amdgcn_s_setprio(1); PG8_MMAQ(0, 0, At, B0); PG8_MMAQ(0, 1, At, B1); __builtin_amdgcn_s_setprio(0); PG8_BAR; PG8_SCHED;
            PG8_LDA(At, 1, 1); PG8_STAGE(PG8_SB(1, 0), b3, voffB); PG8_STAGE(PG8_SB(1, 1), b3 + hstep, voffB); PG8_STAGE(PG8_SA(1, 0), a3, voffA);
            PG8_WAIT_V(8); PG8_WAIT_L(0); PG8_BAR; __builtin_amdgcn_s_setprio(1); PG8_MMAQ(1, 0, At, B0); PG8_MMAQ(1, 1, At, B1); __builtin_amdgcn_s_setprio(0); PG8_BAR; PG8_SCHED;
            } else {
            PG8_LDB(B0, 0, 0); PG8_SCHED; PG8_LDA(At, 0, 0); PG8_STAGE(PG8_SA(1, 1), a1 + hstep, voffA);
            PG8_WAIT_L(8); PG8_BAR; PG8_WAIT_L(0); PG8_MMA(0, 0, At, B0); PG8_BAR; PG8_SCHED;
            PG8_LDB(B1, 0, 1); PG8_STAGE(PG8_SB(0, 0), b2, voffB);
            PG8_BAR; PG8_WAIT_L(0); PG8_MMA(0, 1, At, B1); PG8_BAR;
            PG8_LDA(At, 0, 1); PG8_STAGE(PG8_SA(0, 0), a2, voffA);
            PG8_BAR; PG8_WAIT_L(0); PG8_MMA(1, 0, At, B0); PG8_BAR; PG8_SCHED;
            PG8_STAGE(PG8_SB(0, 1), b2 + hstep, voffB);
            PG8_WAIT_V(6); PG8_BAR; PG8_MMA(1, 1, At, B1); PG8_BAR;
            PG8_LDB(B0, 1, 0); PG8_SCHED; PG8_LDA(At, 1, 0); PG8_STAGE(PG8_SA(0, 1), a2 + hstep, voffA);
            PG8_WAIT_L(8); PG8_BAR; PG8_WAIT_L(0); PG8_MMA(0, 0, At, B0); PG8_BAR; PG8_SCHED;
            PG8_LDB(B1, 1, 1); PG8_STAGE(PG8_SB(1, 0), b3, voffB);
            PG8_BAR; PG8_WAIT_L(0); PG8_MMA(0, 1, At, B1); PG8_BAR;
            PG8_LDA(At, 1, 1); PG8_STAGE(PG8_SA(1, 0), a3, voffA);
            PG8_BAR; PG8_WAIT_L(0); PG8_MMA(1, 0, At, B0); PG8_BAR; PG8_SCHED;
            PG8_STAGE(PG8_SB(1, 1), b3 + hstep, voffB);
            PG8_WAIT_V(6); PG8_BAR; PG8_MMA(1, 1, At, B1); PG8_BAR;
            }
        }
        if constexpr (ALIGN_EPI) { if (wr == 0) PG8_BAR; }
        if constexpr (!Epi::AFTER_DRAIN) { E(acc, cur, wr, wc, fr, fq); S.done(cur); }
        if (!has_next) break;
#pragma unroll
        for (int a = 0; a < 2; ++a)
#pragma unroll
            for (int b = 0; b < 2; ++b)
#pragma unroll
                for (int m = 0; m < 4; ++m)
#pragma unroll
                    for (int n = 0; n < 2; ++n) acc[a][b][m][n] = (f32x4){0.f, 0.f, 0.f, 0.f};
        cur = nxt; cA = nA; cB = nB; ++ui;
        if constexpr (ALIGN_EPI) { if (wr == 1) PG8_BAR; }
    }
    PG8_WAIT_V(0);
    if constexpr (!ALIGN_EPI) { if (wr == 0) PG8_BAR; }
    PG8_BAR;
    if constexpr (Epi::AFTER_DRAIN) { E.fused(acc, cur, wr, wc, fr, fq, lds, wid, lane); S.done(cur); }
#undef PG8_SA
#undef PG8_SB
#undef PG8_STAGE
#undef PG8_LDA
#undef PG8_LDB
#undef PG8_MMA
#undef PG8_MMAQ
#undef PG8_WAIT_V
#undef PG8_WAIT_L
#undef PG8_BAR
#undef PG8_SCHED
}
}

#include <hip/hip_cooperative_groups.h>
#include <cstdio>
#include <cstdint>
namespace cg = cooperative_groups;
using pg8::bf16_t; using pg8::bf16x8; using pg8::f32x4; using pg8::u32x4; using pg8::cvt_pk_bf16;
typedef unsigned u32;
typedef u32 u32x2 __attribute__((ext_vector_type(2)));
typedef float f32x16 __attribute__((ext_vector_type(16)));
typedef float f32x2_t __attribute__((ext_vector_type(2)));

#ifndef MK_MULTI
#define MK_MULTI 0
#endif
#define LAS __attribute__((address_space(3)))
#define XB_TMO      128
#define XB_XCNT(j)  (256  + 64 * (j))
#define XB_XSUB(j)  (1280 + 64 * (j))
#define XB_XGEN(j)  (2304 + 64 * (j))
#define XB_TOP      3328
#define XB_TOPGEN   3392
#define XCD_BAR_WORDS 3456
#define XB_SPIN_CAP (1u << 18)

__device__ __forceinline__ unsigned xb_ld(unsigned* p)              { return __hip_atomic_load(p, __ATOMIC_RELAXED, __HIP_MEMORY_SCOPE_AGENT); }
__device__ __forceinline__ unsigned xb_add(unsigned* p, unsigned v) { return __hip_atomic_fetch_add(p, v, __ATOMIC_RELAXED, __HIP_MEMORY_SCOPE_AGENT); }
__device__ __forceinline__ unsigned xb_xcc_id() { return (unsigned)__builtin_amdgcn_s_getreg((3 << 11) | 20) & 0xFu; }
#define XB_SPIN(cond, bar) do { unsigned _sp = 0; while (cond) { __builtin_amdgcn_s_sleep(1); \
    if ((++_sp & 255u) == 0u) { if (xb_ld(&(bar)[XB_TMO])) break; if (_sp > XB_SPIN_CAP) { atomicAdd(&(bar)[XB_TMO], 1u); break; } } } } while (0)

struct XcdBarrier {
    unsigned* bar; unsigned x; unsigned G;
    volatile LAS unsigned* st;
};

__device__ __forceinline__ XcdBarrier xcd_barrier_post(unsigned* bar, volatile LAS unsigned* st, unsigned G) {
    XcdBarrier b; b.bar = bar; b.x = xb_xcc_id(); b.st = st; b.G = G;
    if (threadIdx.x == 0) (void)xb_add(&bar[XB_XCNT(b.x)], 1u);
    return b;
}
__device__ __forceinline__ void xcd_barrier_complete(unsigned* bar, unsigned x, const unsigned G, unsigned& nloc, unsigned& nx) {
    unsigned sum, cnt, mine, sp = 0u;
    for (;;) {
        sum = 0u; cnt = 0u; mine = 0u;
#pragma unroll
        for (unsigned j = 0; j < 16; ++j) { const unsigned c = xb_ld(&bar[XB_XCNT(j)]); sum += c; cnt += (c > 0u) ? 1u : 0u; mine = (j == x) ? c : mine; }
        if (sum == G) break;
        __builtin_amdgcn_s_sleep(1);
        if ((++sp & 255u) == 0u) { if (xb_ld(&bar[XB_TMO])) break; if (sp > XB_SPIN_CAP) { atomicAdd(&bar[XB_TMO], 1u); break; } }
    }
    nloc = mine > 0u ? mine : 1u; nx = cnt > 0u ? cnt : 1u;
}

__device__ __forceinline__ void xcd_barrier(const XcdBarrier& b) {
    asm volatile("s_waitcnt vmcnt(0)" ::: "memory");
    __syncthreads();
    if (threadIdx.x == 0) {
        unsigned* bar = b.bar;
        __builtin_amdgcn_s_waitcnt(0);
        unsigned nloc = b.st[0], nx = b.st[1];
        if (nloc == 0u) { xcd_barrier_complete(bar, b.x, b.G, nloc, nx); b.st[0] = nloc; b.st[1] = nx; }
        const unsigned old = xb_add(&bar[XB_XSUB(b.x)], 1u);
        const unsigned gen = old / nloc;
        if (old + 1u == (gen + 1u) * nloc) {
            __builtin_amdgcn_fence(__ATOMIC_RELEASE, "agent");
            asm volatile("s_waitcnt vmcnt(0)" ::: "memory");
            const unsigned og = xb_add(&bar[XB_TOP], 1u);
            const unsigned tg = og / nx;
            if (og + 1u == (tg + 1u) * nx) xb_add(&bar[XB_TOPGEN], 1u);
            else XB_SPIN(xb_ld(&bar[XB_TOPGEN]) == tg, bar);
            __builtin_amdgcn_fence(__ATOMIC_ACQUIRE, "agent");
            xb_add(&bar[XB_XGEN(b.x)], 1u);
            asm volatile("s_waitcnt vmcnt(0)" ::: "memory");
        } else {
            XB_SPIN(xb_ld(&bar[XB_XGEN(b.x)]) == gen, bar);
            __builtin_amdgcn_fence(__ATOMIC_ACQUIRE, "agent");
            asm volatile("s_waitcnt vmcnt(0)" ::: "memory");
        }
    }
    __syncthreads();
}


constexpr int M_TOK = 65536, DM = 1024, SEQ = 8192;
constexpr int N_PHASES = 10;
constexpr int LDS_BYTES = 147456;
constexpr float RMS_EPS = 1e-6f;

constexpr size_t MiB = 1024ull * 1024ull;
constexpr size_t WS_WIN = 0, WS_WGLU = 4 * MiB, WS_WOUT = 5 * MiB, WS_WUP = 8 * MiB, WS_WDN = 16 * MiB;
constexpr size_t WS_TWST = 24 * MiB, WS_TWOUT = 26 * MiB, WS_TKT = 28 * MiB, WS_TSC = 29 * MiB, WS_BAR = 30 * MiB;
constexpr size_t WS_SS = 31 * MiB;
constexpr size_t WS_RINV = 31 * MiB + 512 * 1024;
constexpr size_t BAR_STRIDE = 16384, BAR_BYTES = 3 * BAR_STRIDE;
constexpr int LDS_ST_OFF = 147440;
constexpr size_t WS_GROUP0 = 32 * MiB, GROUP_BYTES = 464 * MiB;
constexpr size_t G_X1B = 0  , G_SWS = 0, G_CWS = 32 * MiB, G_U3 = 48 * MiB, G_HN = 80 * MiB, G_O = 144 * MiB, G_BIG = 208 * MiB;
constexpr size_t G_PROJ = G_BIG, G_YG = G_BIG + 96 * MiB, G_YGLU = G_BIG + 128 * MiB, G_YCAT = G_BIG + 160 * MiB, G_H = G_BIG;
constexpr size_t WS_END = WS_GROUP0 + 2 * GROUP_BYTES;
constexpr int KT_ELEMS = 17 * 256, KT_PLANE = 17 * 128;
constexpr int M_HALF = M_TOK / 2;

struct Ctx { int grp, vb, GV, m0; unsigned char* wsg; };

struct Args { const float* in[21]; float* out; unsigned char* ws; int ph_lo, ph_hi; };

__device__ __forceinline__ float bf_lo(u32 w) { return __uint_as_float(w << 16); }
__device__ __forceinline__ float bf_hi(u32 w) { return __uint_as_float(w & 0xffff0000u); }
__device__ __forceinline__ bf16_t f2bf(float f) { return (bf16_t)(cvt_pk_bf16(f, 0.f) & 0xffffu); }
__device__ __forceinline__ float wave_sum(float v) {
#pragma unroll
    for (int o = 1; o < 64; o <<= 1) v += __shfl_xor(v, o);
    return v;
}
__device__ __forceinline__ float fast_rcp(float x) { return __builtin_amdgcn_rcpf(x); }
__device__ __forceinline__ float sigmoidf_(float v) { return fast_rcp(1.f + __expf(-v)); }
__device__ __forceinline__ float gelu_tanh(float v) {
    const float t = v * (-2.3022082f + -0.10294324f * (v * v)); return v * fast_rcp(1.f + __builtin_amdgcn_exp2f(t)); }

struct EpiProj {
    static constexpr bool PERM = true, AFTER_DRAIN = false;
    bf16_t* U3; bf16_t* P;
    __device__ __forceinline__ void operator()(const f32x4 (&acc)[2][2][4][2], const pg8::Unit& u, int wr, int wc, int fr, int fq) const {
        const int row0 = u.pm * 256 + wr * 64 + fr, colb = u.pn * 256 + wc * 32 + 8 * fq;
#pragma unroll
        for (int ai = 0; ai < 2; ++ai)
#pragma unroll
            for (int m = 0; m < 4; ++m) {
                const int row = row0 + ai * 128 + m * 16;
                if (u.pn >= 2 && u.pn < 6) {
                    const f32x4 h0 = acc[ai][0][m][0], c0 = acc[ai][0][m][1], h1 = acc[ai][1][m][0], c1 = acc[ai][1][m][1];
                    u32x4 z; z.x = cvt_pk_bf16(h0[0] * c0[0], h0[1] * c0[1]); z.y = cvt_pk_bf16(h0[2] * c0[2], h0[3] * c0[3]); z.z = cvt_pk_bf16(h1[0] * c1[0], h1[1] * c1[1]); z.w = cvt_pk_bf16(h1[2] * c1[2], h1[3] * c1[3]);
                    *(u32x4*)(P + (size_t)row * 1024 + (u.pn - 2) * 128 + wc * 32 + 8 * fq) = z;
                } else {
#pragma unroll
                    for (int bj = 0; bj < 2; ++bj) {
                        const int col = colb + bj * 128;
                        const f32x4 v0 = acc[ai][bj][m][0], v1 = acc[ai][bj][m][1];
                        u32x4 w; w.x = cvt_pk_bf16(v0[0], v0[1]); w.y = cvt_pk_bf16(v0[2], v0[3]); w.z = cvt_pk_bf16(v1[0], v1[1]); w.w = cvt_pk_bf16(v1[2], v1[3]);
                        if (u.pn < 2) {
                            const int b = row >> 13, tl = row & 8191, g = col >> 4, hf = (col >> 3) & 1;
                            const size_t off = (((size_t)(b * 32 + g) * 8192 + tl) * 2 + hf) * 8;
                            *(u32x4*)(U3 + off) = w;
                        } else {
                            *(u32x4*)(P + (size_t)row * 1024 + 512 + (col - 1536)) = w;
                        }
                    }
                }
            }
    }
};
template <int ACT  > struct EpiStore {
    static constexpr bool PERM = true, AFTER_DRAIN = false;
    bf16_t* O; int ldc;
    __device__ __forceinline__ void operator()(const f32x4 (&acc)[2][2][4][2], const pg8::Unit& u, int wr, int wc, int fr, int fq) const {
        const int row0 = u.pm * 256 + wr * 64 + fr, colb = u.pn * 256 + wc * 32 + 8 * fq;
#pragma unroll
        for (int ai = 0; ai < 2; ++ai)
#pragma unroll
            for (int m = 0; m < 4; ++m) {
                bf16_t* rowp = O + (size_t)(row0 + ai * 128 + m * 16) * ldc + colb;
#pragma unroll
                for (int bj = 0; bj < 2; ++bj) {
                    f32x4 v0 = acc[ai][bj][m][0], v1 = acc[ai][bj][m][1];
                    if (ACT == 1) {
#pragma unroll
                        for (int j = 0; j < 4; ++j) {
                            float a0, a1; asm("v_max_f32 %0, 0, %1" : "=v"(a0) : "v"(v0[j])); asm("v_max_f32 %0, 0, %1" : "=v"(a1) : "v"(v1[j]));
                            f32x2_t p = (f32x2_t){a0, a1}; p = p * p; v0[j] = p.x; v1[j] = p.y; }
                    }
                    u32x4 w; w.x = cvt_pk_bf16(v0[0], v0[1]); w.y = cvt_pk_bf16(v0[2], v0[3]); w.z = cvt_pk_bf16(v1[0], v1[1]); w.w = cvt_pk_bf16(v1[2], v1[3]);
                    *(u32x4*)(rowp + bj * 128) = w;
                }
            }
    }
};
template <int ACT  > struct EpiStoreBlk {
    static constexpr bool PERM = true, AFTER_DRAIN = false;
    bf16_t* O; int ldc;
    __device__ __forceinline__ void operator()(const f32x4 (&acc)[2][2][4][2], const pg8::Unit& u, int wr, int wc, int fr, int fq) const {
        const int rb0 = u.pm * 16 + wr * 4, cb0 = u.pn * 8 + wc, cbs = ldc >> 5;
#pragma unroll
        for (int ai = 0; ai < 2; ++ai)
#pragma unroll
            for (int m = 0; m < 4; ++m) {
#pragma unroll
                for (int bj = 0; bj < 2; ++bj) {
                    f32x4 v0 = acc[ai][bj][m][0], v1 = acc[ai][bj][m][1];
                    if (ACT == 1) {
#pragma unroll
                        for (int j = 0; j < 4; ++j) {
                            float a0, a1; asm("v_max_f32 %0, 0, %1" : "=v"(a0) : "v"(v0[j])); asm("v_max_f32 %0, 0, %1" : "=v"(a1) : "v"(v1[j]));
                            f32x2_t p = (f32x2_t){a0, a1}; p = p * p; v0[j] = p.x; v1[j] = p.y; }
                    }
                    u32x4 w; w.x = cvt_pk_bf16(v0[0], v0[1]); w.y = cvt_pk_bf16(v0[2], v0[3]); w.z = cvt_pk_bf16(v1[0], v1[1]); w.w = cvt_pk_bf16(v1[2], v1[3]);
                    const size_t off = (((size_t)(rb0 + ai * 8 + m) * cbs + (cb0 + bj * 4)) * 16 + fr) * 32 + 8 * fq;
                    *(u32x4*)(O + off) = w;
                }
            }
    }
};
struct EpiGlu {
    static constexpr bool PERM = true, AFTER_DRAIN = false;
    const bf16_t* Y; bf16_t* O; const float* gs; float* SS;
    __device__ __forceinline__ void operator()(const f32x4 (&acc)[2][2][4][2], const pg8::Unit& u, int wr, int wc, int fr, int fq) const {
        const int row0 = u.pm * 256 + wr * 64 + fr, colb = u.pn * 256 + wc * 32 + 8 * fq;
        f32x4 g[2][2];
#pragma unroll
        for (int bj = 0; bj < 2; ++bj) { g[bj][0] = *(const f32x4*)(gs + colb + bj * 128); g[bj][1] = *(const f32x4*)(gs + colb + bj * 128 + 4); }
#pragma unroll
        for (int ai = 0; ai < 2; ++ai)
#pragma unroll
            for (int m = 0; m < 4; ++m) {
                const int row = row0 + ai * 128 + m * 16;
                float ss = 0.f;
#pragma unroll
                for (int bj = 0; bj < 2; ++bj) {
                    const f32x4 v0 = acc[ai][bj][m][0], v1 = acc[ai][bj][m][1];
                    const u32x4 y = *(const u32x4*)(Y + (size_t)row * 512 + colb + bj * 128);
                    f32x4 t0, t1;
                    t0[0] = bf_lo(y.x) * sigmoidf_(v0[0]); t0[1] = bf_hi(y.x) * sigmoidf_(v0[1]); t0[2] = bf_lo(y.y) * sigmoidf_(v0[2]); t0[3] = bf_hi(y.y) * sigmoidf_(v0[3]);
                    t1[0] = bf_lo(y.z) * sigmoidf_(v1[0]); t1[1] = bf_hi(y.z) * sigmoidf_(v1[1]); t1[2] = bf_lo(y.w) * sigmoidf_(v1[2]); t1[3] = bf_hi(y.w) * sigmoidf_(v1[3]);
                    ss += (t0[0] * t0[0] + t0[1] * t0[1]) + (t0[2] * t0[2] + t0[3] * t0[3]) + (t1[0] * t1[0] + t1[1] * t1[1]) + (t1[2] * t1[2] + t1[3] * t1[3]);
                    t0 = t0 * g[bj][0]; t1 = t1 * g[bj][1];
                    u32x4 w; w.x = cvt_pk_bf16(t0[0], t0[1]); w.y = cvt_pk_bf16(t0[2], t0[3]); w.z = cvt_pk_bf16(t1[0], t1[1]); w.w = cvt_pk_bf16(t1[2], t1[3]);
                    *(u32x4*)(O + (size_t)row * 1024 + colb + bj * 128) = w;
                }
                ss += __shfl_xor(ss, 16); ss += __shfl_xor(ss, 32);
                if (fq == 0) unsafeAtomicAdd(SS + row, ss);
            }
    }
};

__device__ __forceinline__ void cpowd(double lrdt, double lidt, double k, float& re, float& im) {
    const double mag = exp(lrdt * k);
    double ang = lidt * k;
    ang -= 6.283185307179586476925 * rint(ang * 0.15915494309189533577);
    re = (float)(mag * cos(ang)); im = (float)(mag * sin(ang));
}
__device__ __forceinline__ void transpose_item(const float* W, int K, int N, bf16_t* WT, float* scr, int item, int lane, const float* gk = nullptr, bool win_map = false) {
    const int nblk = N / 32, kb = item / nblk, nb = item % nblk, k0 = 64 * kb, n0 = 32 * nb;
#pragma unroll 8
    for (int i = 0; i < 32; ++i) { const int kk = 2 * i + (lane >> 5); float w = W[(size_t)(k0 + kk) * N + n0 + (lane & 31)]; if (gk) w *= gk[k0 + kk]; scr[kk * 33 + (lane & 31)] = w; }
    __builtin_amdgcn_s_waitcnt(0xc07f); asm volatile("" ::: "memory");
    const int c = lane & 7;
#pragma unroll
    for (int j = 0; j < 4; ++j) { const int n = (lane >> 3) + 8 * j; const float* s = scr + (8 * c) * 33 + n;
        u32x4 o; o.x = cvt_pk_bf16(s[0 * 33], s[1 * 33]); o.y = cvt_pk_bf16(s[2 * 33], s[3 * 33]); o.z = cvt_pk_bf16(s[4 * 33], s[5 * 33]); o.w = cvt_pk_bf16(s[6 * 33], s[7 * 33]);
        int nr = n0 + n;
        if (win_map && nr >= 512) {
            if (nr < 1024 || nr >= 1536) { const int nn = nr >= 1536, ch = nr - (nn ? 1536 : 512), r = ch & 127;
                nr = 512 + 256 * (ch >> 7) + 128 * ((r >> 2) & 1) + 32 * (r >> 5) + 8 * ((r >> 3) & 3) + 4 * nn + (r & 3); }
            else nr = nr + 512;
        }
        *(u32x4*)(WT + (size_t)nr * K + k0 + 8 * c) = o; }
    __builtin_amdgcn_s_waitcnt(0xc07f); asm volatile("" ::: "memory");
}
__device__ __forceinline__ void phase_prep_w(const Args& a, const Ctx& c, unsigned char* lds) {
    const int tid = threadIdx.x, lane = tid & 63, wave = tid >> 6;
    const int gw = c.vb * 8 + wave, NGW = c.GV * 8;
    unsigned char* ws = a.ws;
    {
        const float* lam_re = a.in[3]; const float* lam_im = a.in[4]; const float* log_dt = a.in[5];
        const float* b_re = a.in[6]; const float* b_im = a.in[7]; const float* c_re = a.in[8]; const float* c_im = a.in[9]; const float* d_skip = a.in[10];
        float2* shpow = (float2*)(lds + 69632);
        float2* shcoef = (float2*)(lds + 69632 + 6144);
        float2* shB = (float2*)(lds + 69632 + 8192);
        float2* shC = (float2*)(lds + 69632 + 16384);
        bf16_t* TWST = (bf16_t*)(ws + WS_TWST); bf16_t* TWOUT = (bf16_t*)(ws + WS_TWOUT); bf16_t* TKT = (bf16_t*)(ws + WS_TKT); float4* TSC = (float4*)(ws + WS_TSC);
        for (int it = c.vb; it < 128; it += c.GV) {
            const int g = it >> 2, jq = it & 3;
            if (tid < 256) {
                const int p = tid & 63, jj = tid >> 6, j = 4 * jq + jj;
                const double dt = exp((double)log_dt[g]);
                const double lr = (double)lam_re[g * 64 + p], li = (double)lam_im[g * 64 + p];
                const double lrdt = lr * dt, lidt = li * dt;
                const double mag = exp(lrdt); double ang = lidt; ang -= 6.283185307179586476925 * rint(ang * 0.15915494309189533577);
                const double a1r = mag * cos(ang), a1i = mag * sin(ang);
                double pjr = 1.0, pji = 0.0, pqr = 1.0, pqi = 0.0;
                for (int k = 0; k < j; ++k) { const double t = pjr * a1r - pji * a1i; pji = pjr * a1i + pji * a1r; pjr = t; }
                for (int k = 0; k < 15 - j; ++k) { const double t = pqr * a1r - pqi * a1i; pqi = pqr * a1i + pqi * a1r; pqr = t; }
                const double p1r = pjr * a1r - pji * a1i, p1i = pjr * a1i + pji * a1r;
                shpow[(jj * 3 + 0) * 64 + p] = make_float2((float)pjr, (float)pji); shpow[(jj * 3 + 1) * 64 + p] = make_float2((float)pqr, (float)pqi); shpow[(jj * 3 + 2) * 64 + p] = make_float2((float)p1r, (float)p1i);
                if (jj == 0) {
                    const double nr = a1r - 1.0, ni = a1i, den = lr * lr + li * li;
                    shcoef[p] = make_float2((float)((nr * lr + ni * li) / den), (float)((ni * lr - nr * li) / den));
                    if (jq == 0) {
                        const double s16r = p1r * pqr - p1i * pqi, s16i = p1r * pqi + p1i * pqr;
                        double br = s16r, bi = s16i;
#pragma unroll
                        for (int k = 0; k < 6; ++k) { const double t = br * br - bi * bi; bi = 2.0 * br * bi; br = t; }
                        TSC[g * 64 + p] = make_float4((float)s16r, (float)s16i, (float)br, (float)bi);
                    }
                }
            }
            __syncthreads();
#pragma unroll
            for (int i = 0; i < 2; ++i) {
                const int e = tid + 512 * i;
                { const int p = e >> 4; const float2 co = shcoef[p]; const float br = b_re[g * 1024 + e], bi = b_im[g * 1024 + e]; shB[e] = make_float2(co.x * br - co.y * bi, co.x * bi + co.y * br); }
                shC[e] = make_float2(c_re[g * 1024 + e], c_im[g * 1024 + e]);
            }
            __syncthreads();
#pragma unroll
            for (int i = 0; i < 2; ++i) {
                const int e = tid + 512 * i, jj = e >> 8, hp = (e >> 4) & 15, h = e & 15, j = 4 * jq + jj; float val = 0.f;
#pragma unroll 8
                for (int p = 0; p < 64; ++p) {
                    const float2 A = shpow[(jj * 3 + 0) * 64 + p], bb = shB[p * 16 + h], cc = shC[hp * 64 + p];
                    const float tr = A.x * bb.x - A.y * bb.y, ti = A.x * bb.y + A.y * bb.x;
                    val += cc.x * tr - cc.y * ti;
                }
                if (j == 0 && hp == h) val += d_skip[g * 16 + hp];
                TKT[(size_t)g * KT_ELEMS + (h >> 3) * KT_PLANE + (1 + j) * 128 + hp * 8 + (h & 7)] = f2bf(val);
                if (jq == 0 && e < 256) TKT[(size_t)g * KT_ELEMS + (e >> 7) * KT_PLANE + (e & 127)] = 0;
            }
#pragma unroll 1
            for (int jj = 0; jj < 4; ++jj) {
                const int j = 4 * jq + jj;
#pragma unroll
                for (int i = 0; i < 4; ++i) {
                    const int e = tid + 512 * i;
                    {
                        const int h = e & 15, col = e >> 4, cidx = col >> 6, p = col & 63;
                        const float2 A = shpow[(jj * 3 + 1) * 64 + p], bb = shB[p * 16 + h];
                        const float tr = A.x * bb.x - A.y * bb.y, ti = A.x * bb.y + A.y * bb.x;
                        TWST[(size_t)g * 32768 + j * 2048 + (col >> 5) * 512 + (h >> 3) * 256 + (col & 31) * 8 + (h & 7)] = f2bf(cidx ? ti : tr);
                    }
                    {
                        const int hp = e & 15, p = (e >> 4) & 63, cidx = e >> 10;
                        const float2 A = shpow[(jj * 3 + 2) * 64 + p], cc = shC[hp * 64 + p];
                        const float tr = cc.x * A.x - cc.y * A.y, ti = cc.x * A.y + cc.y * A.x;
                        const int ni = j >> 1, n = (j & 1) * 16 + hp, kk = cidx * 4 + (p >> 4), k = p & 15;
                        TWOUT[(size_t)g * 32768 + (kk * 8 + ni) * 512 + (k >> 3) * 256 + n * 8 + (k & 7)] = f2bf(cidx ? -ti : tr);
                    }
                }
            }
            __syncthreads();
        }
    }
    {
        float* scr = (float*)(lds + wave * 8448);
        constexpr int I_IN = 16 * 64, I_GLU = 8 * 16, I_OUT = 16 * 32, I_UP = 16 * 128, I_DN = 64 * 32;
        constexpr int NITEMS = I_IN + I_GLU + I_OUT + I_UP + I_DN;
        for (int it = gw; it < NITEMS; it += NGW) {
            int r = it;
            if (r < I_IN) { transpose_item(a.in[2], 1024, 2048, (bf16_t*)(ws + WS_WIN), scr, r, lane, nullptr, true); continue; } r -= I_IN;
            if (r < I_GLU) { transpose_item(a.in[11], 512, 512, (bf16_t*)(ws + WS_WGLU), scr, r, lane); continue; } r -= I_GLU;
            if (r < I_OUT) { transpose_item(a.in[15], 1024, 1024, (bf16_t*)(ws + WS_WOUT), scr, r, lane); continue; } r -= I_OUT;
            if (r < I_UP) { transpose_item(a.in[18], 1024, 4096, (bf16_t*)(ws + WS_WUP), scr, r, lane, a.in[17]); continue; } r -= I_UP;
            transpose_item(a.in[19], 4096, 1024, (bf16_t*)(ws + WS_WDN), scr, r, lane);
        }
    }
}
__device__ __forceinline__ float pair_sum(float v) {
    v += __shfl_xor(v, 1); v += __shfl_xor(v, 2); v += __shfl_xor(v, 4); v += __shfl_xor(v, 16); v += __shfl_xor(v, 32); return v;
}
__device__ __forceinline__ void phase_xnorm(const Args& a, const Ctx& c) {
    const int tid = threadIdx.x, lane = tid & 63, wave = tid >> 6;
    const int gw = c.vb * 8 + wave, NGW = c.GV * 8;
    { float* SS = (float*)(a.ws + WS_SS) + (size_t)c.grp * M_HALF; for (int i = c.vb * 512 + tid; i < M_HALF; i += c.GV * 512) SS[i] = 0.f; }
    const float* x = a.in[0] + (size_t)c.m0 * DM; const float* gp = a.in[1]; bf16_t* HN = (bf16_t*)(c.wsg + G_HN); float* RINV = (float*)(a.ws + WS_RINV) + (size_t)c.grp * M_HALF;
    const int sub = (lane >> 3) & 1, cl = 32 * (lane >> 4) + 4 * (lane & 7);
    f32x4 gv[8];
#pragma unroll
    for (int j = 0; j < 8; ++j) gv[j] = *(const f32x4*)(gp + cl + 128 * j);
    f32x4 v[8], nx[8];
#pragma unroll
    for (int j = 0; j < 8; ++j) v[j] = __builtin_nontemporal_load((const f32x4*)(x + (size_t)(2 * gw + sub) * DM + cl + 128 * j));
    for (int pr = gw; pr < M_HALF / 2; pr += NGW) {
        const int pn = pr + NGW, r = 2 * pr;
        if (pn < M_HALF / 2) {
#pragma unroll
            for (int j = 0; j < 8; ++j) nx[j] = __builtin_nontemporal_load((const f32x4*)(x + (size_t)(2 * pn + sub) * DM + cl + 128 * j));
        }
        float ss = 0.f;
#pragma unroll
        for (int j = 0; j < 8; ++j) ss += (v[j].x * v[j].x + v[j].y * v[j].y) + (v[j].z * v[j].z + v[j].w * v[j].w);
        const float q = pair_sum(ss) * (1.f / DM) + RMS_EPS, rr = rsqrtf(q);
        if ((lane & 0x37) == 0) RINV[r + sub] = q * rr;
        bf16_t* hb = HN + (size_t)(r >> 4) * 16384 + (r & 15) * 32 + (lane >> 4) * 512 + (lane & 15) * 4;
#pragma unroll
        for (int j = 0; j < 8; ++j) {
            u32x2 o; o.x = cvt_pk_bf16(v[j].x * rr * gv[j].x, v[j].y * rr * gv[j].y); o.y = cvt_pk_bf16(v[j].z * rr * gv[j].z, v[j].w * rr * gv[j].w);
            *(u32x2*)(hb + j * 2048) = o;
        }
#pragma unroll
        for (int j = 0; j < 8; ++j) v[j] = nx[j];
    }
}

__device__ __forceinline__ f32x16 mfma32(bf16x8 a, bf16x8 b, f32x16 c) { return __builtin_amdgcn_mfma_f32_32x32x16_bf16(a, b, c, 0, 0, 0); }
__device__ __forceinline__ void phase_ssm(const Args& a, const Ctx& c, unsigned char* ldsg) {
    const int tid = threadIdx.x, lane = tid & 63, wave = __builtin_amdgcn_readfirstlane(tid >> 6);
    unsigned char* ws = a.ws;
    const bf16_t* lw = (const bf16_t*)ldsg;
    float2* shE = (float2*)(ldsg + 139776);
    const bf16_t* U3 = (const bf16_t*)(c.wsg + G_U3);
    bf16_t* YG = (bf16_t*)(c.wsg + G_YG);
    const float4* TSC = (const float4*)(ws + WS_TSC);
    const int boff = (lane >> 5) * 256 + (lane & 31) * 8;
    const int koff = (lane >> 5) * KT_PLANE + (lane & 31) * 8;
    for (int item = c.vb; item < 128; item += c.GV) {
        const int b = item >> 5, g = item & 31;
        {
            const u32x4* s0 = (const u32x4*)(ws + WS_TWST + (size_t)g * 65536); u32x4* d0 = (u32x4*)ldsg;
            const u32x4* s1 = (const u32x4*)(ws + WS_TWOUT + (size_t)g * 65536); u32x4* d1 = (u32x4*)(ldsg + 65536);
            const u32x4* s2 = (const u32x4*)(ws + WS_TKT + (size_t)g * (KT_ELEMS * 2)); u32x4* d2 = (u32x4*)(ldsg + 131072);
#pragma unroll
            for (int i = 0; i < 8; ++i) { d0[tid + 512 * i] = s0[tid + 512 * i]; d1[tid + 512 * i] = s1[tid + 512 * i]; }
            for (int i = tid; i < (KT_ELEMS * 2) / 16; i += 512) d2[i] = s2[i];
        }
        __syncthreads();
        const bf16_t* Ubg = U3 + (size_t)item * 131072;
        const bf16_t* Ul = Ubg + (lane & 31) * 256 + (lane >> 5) * 8;
        float* Sw = (float*)(c.wsg + G_SWS) + (size_t)item * 65536;
        bf16_t* Cw = (bf16_t*)(c.wsg + G_CWS) + (size_t)item * 65536;
        for (int q = 0; q < 2; ++q) {
            const int mb = wave * 2 + q;
            bf16x8 ua[16];
#pragma unroll
            for (int s = 0; s < 16; ++s) ua[s] = *(const bf16x8*)(Ul + mb * 8192 + s * 16);
#pragma unroll 1
            for (int nb = 0; nb < 4; ++nb) {
                f32x16 acc;
#pragma unroll
                for (int r = 0; r < 16; ++r) acc[r] = 0.f;
#pragma unroll
                for (int s = 0; s < 16; ++s) { const bf16x8 B = *(const bf16x8*)(lw + (s * 4 + nb) * 512 + boff); acc = mfma32(ua[s], B, acc); }
#pragma unroll
                for (int r = 0; r < 16; ++r) { const int row = (r & 3) + 8 * (r >> 2) + 4 * (lane >> 5); Sw[(size_t)(mb * 32 + row) * 128 + nb * 32 + (lane & 31)] = acc[r]; }
            }
        }
        __builtin_amdgcn_fence(__ATOMIC_RELEASE, "workgroup"); asm volatile("s_waitcnt vmcnt(0)" ::: "memory"); __builtin_amdgcn_fence(__ATOMIC_ACQUIRE, "workgroup");
        {
            const float4 sc = TSC[g * 64 + lane];
            const float* Sp = Sw + (size_t)(wave * 64) * 128 + lane;
            float sr[32], si[32];
            float xr = 0.f, xi = 0.f;
#pragma unroll 1
            for (int hb = 0; hb < 2; ++hb) {
#pragma unroll
                for (int n = 0; n < 32; ++n) { sr[n] = Sp[(hb * 32 + n) * 128]; si[n] = Sp[(hb * 32 + n) * 128 + 64]; }
#pragma unroll
                for (int n = 0; n < 32; ++n) { const float nr = sc.x * xr - sc.y * xi + sr[n], ni = sc.x * xi + sc.y * xr + si[n]; xr = nr; xi = ni; }
            }
            shE[wave * 64 + lane] = make_float2(xr, xi);
            __syncthreads();
            xr = 0.f; xi = 0.f;
            for (int v = 0; v < wave; ++v) { const float2 e = shE[v * 64 + lane]; const float nr = sc.z * xr - sc.w * xi + e.x, ni = sc.z * xi + sc.w * xr + e.y; xr = nr; xi = ni; }
            bf16_t* Cp = Cw + (size_t)(wave * 64) * 128 + lane;
#pragma unroll 1
            for (int hb = 0; hb < 2; ++hb) {
#pragma unroll
                for (int n = 0; n < 32; ++n) { sr[n] = Sp[(hb * 32 + n) * 128]; si[n] = Sp[(hb * 32 + n) * 128 + 64]; }
#pragma unroll
                for (int n = 0; n < 32; ++n) {
                    Cp[(hb * 32 + n) * 128] = f2bf(xr); Cp[(hb * 32 + n) * 128 + 64] = f2bf(xi);
                    const float nr = sc.x * xr - sc.y * xi + sr[n], ni = sc.x * xi + sc.y * xr + si[n]; xr = nr; xi = ni;
                }
            }
        }
        __builtin_amdgcn_fence(__ATOMIC_RELEASE, "workgroup"); asm volatile("s_waitcnt vmcnt(0)" ::: "memory"); __builtin_amdgcn_fence(__ATOMIC_ACQUIRE, "workgroup");
        for (int q = 0; q < 2; ++q) {
            const int mb = wave * 2 + q;
            bf16x8 ua[16], ca[8];
#pragma unroll
            for (int s = 0; s < 16; ++s) ua[s] = *(const bf16x8*)(Ul + mb * 8192 + s * 16);
#pragma unroll
            for (int kk = 0; kk < 8; ++kk) ca[kk] = *(const bf16x8*)(Cw + (size_t)(mb * 32 + (lane & 31)) * 128 + kk * 16 + (lane >> 5) * 8);
#pragma unroll 1
            for (int ni = 0; ni < 8; ++ni) {
                f32x16 acc;
#pragma unroll
                for (int r = 0; r < 16; ++r) acc[r] = 0.f;
#pragma unroll
                for (int s = 0; s < 16; ++s) if (s <= 2 * ni + 1) { const bf16x8 B = *(const bf16x8*)(lw + 65536 + (2 * ni - s + 1) * 128 + koff); acc = mfma32(ua[s], B, acc); }
#pragma unroll
                for (int kk = 0; kk < 8; ++kk) { const bf16x8 B = *(const bf16x8*)(lw + 32768 + (kk * 8 + ni) * 512 + boff); acc = mfma32(ca[kk], B, acc); }
                const int tau = 2 * ni + ((lane & 31) >> 4), hp = lane & 15;
#pragma unroll
                for (int r = 0; r < 16; ++r) {
                    const int row = (r & 3) + 8 * (r >> 2) + 4 * (lane >> 5);
                    const int tl = (mb * 32 + row) * 16 + tau;
                    YG[((size_t)(b * SEQ + tl)) * 512 + g * 16 + hp] = f2bf(gelu_tanh(acc[r]));
                }
            }
        }
        __syncthreads();
    }
}

__device__ __forceinline__ void unpack8(const u32x4 w, float (&f)[8]) { f[0] = bf_lo(w.x); f[1] = bf_hi(w.x); f[2] = bf_lo(w.y); f[3] = bf_hi(w.y); f[4] = bf_lo(w.z); f[5] = bf_hi(w.z); f[6] = bf_lo(w.w); f[7] = bf_hi(w.w); }
__device__ __forceinline__ u32x4 pack8(const float (&f)[8]) { u32x4 w; w.x = cvt_pk_bf16(f[0], f[1]); w.y = cvt_pk_bf16(f[2], f[3]); w.z = cvt_pk_bf16(f[4], f[5]); w.w = cvt_pk_bf16(f[6], f[7]); return w; }
__device__ __forceinline__ void phase_mix(const Args& a, const Ctx& c) {
    const int tid = threadIdx.x, lane = tid & 63, wave = tid >> 6;
    const int gw = c.vb * 8 + wave, NGW = c.GV * 8;
    const bf16_t* P = (const bf16_t*)(c.wsg + G_PROJ); bf16_t* YCAT = (bf16_t*)(c.wsg + G_YCAT); const float* SS = (const float*)(a.ws + WS_SS) + (size_t)c.grp * M_HALF;
    const float* cw = a.in[12]; const float* gc = a.in[14];
    const int j0 = 8 * lane;
    float w0[8], w1[8], w2[8], gcv[8];
#pragma unroll
    for (int j = 0; j < 8; ++j) { w0[j] = cw[j0 + j]; w1[j] = cw[512 + j0 + j]; w2[j] = cw[1024 + j0 + j]; gcv[j] = gc[j0 + j]; }
    constexpr int STRIP = 32;
    for (int st = gw; st < M_HALF / STRIP; st += NGW) {
        const int row0 = st * STRIP;
        float zp2[8], zp1[8];
        if ((row0 & (SEQ - 1)) == 0) {
#pragma unroll
            for (int j = 0; j < 8; ++j) { zp2[j] = 0.f; zp1[j] = 0.f; }
        } else {
            unpack8(*(const u32x4*)(P + (size_t)(row0 - 2) * 1024 + j0), zp2);
            unpack8(*(const u32x4*)(P + (size_t)(row0 - 1) * 1024 + j0), zp1);
        }
        constexpr int PR = 4;
        u32x4 lz[PR], lb[PR], nz[PR], nb[PR]; float ly[PR], ny[PR];
#pragma unroll
        for (int k = 0; k < PR; ++k) { const size_t r = (size_t)(row0 + k); lz[k] = *(const u32x4*)(P + r * 1024 + j0); lb[k] = *(const u32x4*)(P + r * 1024 + 512 + j0); ly[k] = SS[r]; }
        for (int i = 0; i < STRIP; i += PR) {
            if (i + PR < STRIP) {
#pragma unroll
                for (int k = 0; k < PR; ++k) { const size_t r = (size_t)(row0 + i + PR + k); nz[k] = *(const u32x4*)(P + r * 1024 + j0); nb[k] = *(const u32x4*)(P + r * 1024 + 512 + j0); ny[k] = SS[r]; }
            }
#pragma unroll
            for (int k = 0; k < PR; ++k) {
                const int row = row0 + i + k;
                float bg[8], z[8], yc[8];
                unpack8(lz[k], z); unpack8(lb[k], bg);
                float ssc = 0.f;
#pragma unroll
                for (int j = 0; j < 8; ++j) { yc[j] = bg[j] * (w0[j] * zp2[j] + w1[j] * zp1[j] + w2[j] * z[j]); ssc += yc[j] * yc[j]; }
                ssc = wave_sum(ssc);
                const float rc = rsqrtf(ssc * (1.f / 512.f) + RMS_EPS) * sqrtf(ly[k] * (1.f / 512.f) + RMS_EPS);
#pragma unroll
                for (int j = 0; j < 8; ++j) { yc[j] = yc[j] * rc * gcv[j]; zp2[j] = zp1[j]; zp1[j] = z[j]; }
                *(u32x4*)(YCAT + (size_t)row * 1024 + 512 + j0) = pack8(yc);
            }
#pragma unroll
            for (int k = 0; k < PR; ++k) { lz[k] = nz[k]; lb[k] = nb[k]; ly[k] = ny[k]; }
        }
    }
}

__device__ __forceinline__ void phase_resid6(const Args& a, const Ctx& c) {
    const int tid = threadIdx.x, lane = tid & 63, wave = tid >> 6;
    const int gw = c.vb * 8 + wave, NGW = c.GV * 8;
    const bf16_t* HN = (const bf16_t*)(c.wsg + G_HN); const float* RINV = (const float*)(a.ws + WS_RINV) + (size_t)c.grp * M_HALF;
    const bf16_t* O = (const bf16_t*)(c.wsg + G_O); bf16_t* X1B = (bf16_t*)(c.wsg + G_X1B);
    const float* SS = (const float*)(a.ws + WS_SS) + (size_t)c.grp * M_HALF;
    const int sub = (lane >> 3) & 1, cl = 32 * (lane >> 4) + 4 * (lane & 7), lo = (lane >> 4) * 512 + (lane & 15) * 4;
    f32x4 g1[8], gi[8];
#pragma unroll
    for (int j = 0; j < 8; ++j) { g1[j] = *(const f32x4*)(a.in[16] + cl + 128 * j); const f32x4 g0 = *(const f32x4*)(a.in[1] + cl + 128 * j); gi[j] = (f32x4){1.f / g0.x, 1.f / g0.y, 1.f / g0.z, 1.f / g0.w}; }
    u32x2 xv[8], nxv[8], ov[8], nov[8]; float ssv, nssv = 0.f, riv, nriv = 0.f;
    { const int r = 2 * gw; const size_t bo = (size_t)(r >> 4) * 16384 + (r & 15) * 32 + lo; ssv = SS[r + sub]; riv = RINV[r + sub];
#pragma unroll
      for (int j = 0; j < 8; ++j) { xv[j] = *(const u32x2*)(HN + bo + j * 2048); ov[j] = *(const u32x2*)(O + bo + j * 2048); } }
    for (int pr = gw; pr < M_HALF / 2; pr += NGW) {
        const int pn = pr + NGW, r = 2 * pr;
        if (pn < M_HALF / 2) { const int rn = 2 * pn; const size_t bo = (size_t)(rn >> 4) * 16384 + (rn & 15) * 32 + lo; nssv = SS[rn + sub]; nriv = RINV[rn + sub];
#pragma unroll
            for (int j = 0; j < 8; ++j) { nxv[j] = *(const u32x2*)(HN + bo + j * 2048); nov[j] = *(const u32x2*)(O + bo + j * 2048); } }
        f32x4 of[8]; float so = 0.f;
#pragma unroll
        for (int j = 0; j < 8; ++j) { of[j] = (f32x4){bf_lo(ov[j].x), bf_hi(ov[j].x), bf_lo(ov[j].y), bf_hi(ov[j].y)}; so += (of[j].x * of[j].x + of[j].y * of[j].y) + (of[j].z * of[j].z + of[j].w * of[j].w); }
        const float ro = rsqrtf(pair_sum(so) * (1.f / DM) + RMS_EPS * (ssv * (1.f / 512.f) + RMS_EPS));
        bf16_t* xb = X1B + (size_t)(r >> 4) * 16384 + (r & 15) * 32 + lo;
#pragma unroll
        for (int j = 0; j < 8; ++j) {
            const f32x4 xr = (f32x4){bf_lo(xv[j].x), bf_hi(xv[j].x), bf_lo(xv[j].y), bf_hi(xv[j].y)} * gi[j] * riv;
            const f32x4 x1 = xr + of[j] * ro * g1[j];
            u32x2 q; q.x = cvt_pk_bf16(x1.x, x1.y); q.y = cvt_pk_bf16(x1.z, x1.w); *(u32x2*)(xb + j * 2048) = q;
        }
#pragma unroll
        for (int j = 0; j < 8; ++j) { xv[j] = nxv[j]; ov[j] = nov[j]; }
        ssv = nssv; riv = nriv;
    }
}
__device__ __forceinline__ void phase_final(const Args& a, const Ctx& c, int tg, int p_lo, int p_hi) {
    const int tid = threadIdx.x, lane = tid & 63, wave = tid >> 6;
    const int gw = p_lo + c.vb * 8 + wave, NGW = c.GV * 8;
    if (gw >= p_hi) return;
    float* outp = a.out + (size_t)tg * M_HALF * DM;
    const unsigned char* wst = a.ws + WS_GROUP0 + (size_t)tg * GROUP_BYTES;
    const bf16_t* MO = (const bf16_t*)(wst + G_HN); const bf16_t* X1B = (const bf16_t*)(wst + G_X1B);
    const int sub = (lane >> 3) & 1, cl = 32 * (lane >> 4) + 4 * (lane & 7), lo = (lane >> 4) * 512 + (lane & 15) * 4;
    f32x4 g2[8];
#pragma unroll
    for (int j = 0; j < 8; ++j) g2[j] = *(const f32x4*)(a.in[20] + cl + 128 * j);
    u32x2 xv[8], nxv[8], mv[8], nmv[8];
    { const int r = 2 * gw; const size_t bo = (size_t)(r >> 4) * 16384 + (r & 15) * 32 + lo;
#pragma unroll
      for (int j = 0; j < 8; ++j) { xv[j] = *(const u32x2*)(X1B + bo + j * 2048); mv[j] = *(const u32x2*)(MO + bo + j * 2048); } }
    for (int pr = gw; pr < p_hi; pr += NGW) {
        const int pn = pr + NGW, r = 2 * pr;
        if (pn < p_hi) { const int rn = 2 * pn; const size_t bo = (size_t)(rn >> 4) * 16384 + (rn & 15) * 32 + lo;
#pragma unroll
            for (int j = 0; j < 8; ++j) { nxv[j] = *(const u32x2*)(X1B + bo + j * 2048); nmv[j] = *(const u32x2*)(MO + bo + j * 2048); } }
        f32x4 mf[8], x1[8]; float sm = 0.f, s1 = 0.f;
#pragma unroll
        for (int j = 0; j < 8; ++j) { mf[j] = (f32x4){bf_lo(mv[j].x), bf_hi(mv[j].x), bf_lo(mv[j].y), bf_hi(mv[j].y)};
            x1[j] = (f32x4){bf_lo(xv[j].x), bf_hi(xv[j].x), bf_lo(xv[j].y), bf_hi(xv[j].y)};
            sm += (mf[j].x * mf[j].x + mf[j].y * mf[j].y) + (mf[j].z * mf[j].z + mf[j].w * mf[j].w);
            s1 += (x1[j].x * x1[j].x + x1[j].y * x1[j].y) + (x1[j].z * x1[j].z + x1[j].w * x1[j].w); }
        sm = pair_sum(sm); s1 = pair_sum(s1);
        const float q1 = s1 * (1.f / DM) + RMS_EPS;
        const float rm = rsqrtf(sm * (1.f / DM) + RMS_EPS * q1 * q1);
        float* ob = outp + (size_t)(r + sub) * DM + cl;
#pragma unroll
        for (int j = 0; j < 8; ++j) __builtin_nontemporal_store(x1[j] + mf[j] * rm * g2[j], (f32x4*)(ob + 128 * j));
#pragma unroll
        for (int j = 0; j < 8; ++j) { xv[j] = nxv[j]; mv[j] = nmv[j]; }
    }
}

template <class Epi, bool ABLK = false> __device__ __forceinline__ void run_gemm(unsigned char* lds, const Ctx& c, const bf16_t* A, const bf16_t* Bt, int N, int K, const Epi& E, int rev = 0) {
    pg8::StaticOrder S; S.init(M_HALF, N, c.GV, c.vb, 4, rev);
    pg8::gemm_phase<Epi, pg8::StaticOrder, true, true, ABLK>((PG8_LAS unsigned char*)lds, pg8::Gemm{A, Bt, M_HALF, N, K}, S, E);
}
#ifdef PROBE_DUMMY
struct ProbeOrder : pg8::StaticOrder {
    int mode;
    __device__ bool next(int i, pg8::Unit& u) const { if (mode) { if (i >= 16) return false; u.pm = 0; u.pn = 0; return true; } return pg8::StaticOrder::next(i, u); }
};
#endif
__global__ void __launch_bounds__(512, 2) hymba_fwd(Args a) {
    extern __shared__ __attribute__((aligned(16))) unsigned char lds[];
    Ctx c;
    c.GV = (int)gridDim.x >> 1; c.grp = ((int)blockIdx.x & 7) >> 2; c.vb = (((int)blockIdx.x >> 3) << 2) | ((int)blockIdx.x & 3);
    c.m0 = c.grp * M_HALF; c.wsg = a.ws + WS_GROUP0 + (size_t)c.grp * GROUP_BYTES;
    unsigned char* ws = a.ws; unsigned char* wsg = c.wsg;
    volatile LAS unsigned* st = (volatile LAS unsigned*)((LAS unsigned char*)lds + LDS_ST_OFF);
    if (threadIdx.x < 4) st[threadIdx.x] = 0u;
    __syncthreads();
    const XcdBarrier gb = xcd_barrier_post((unsigned*)(ws + WS_BAR + (size_t)c.grp * BAR_STRIDE), st, (unsigned)c.GV);
    unsigned* wready = (unsigned*)(ws + WS_BAR + 2 * BAR_STRIDE);
    if (a.ph_lo < 0) cg::this_grid().sync();
    if (c.grp == 1) {
        phase_prep_w(a, c, lds);
#if defined(PROBE_X2) && (PROBE_X2 & 1)
        __syncthreads(); phase_prep_w(a, c, lds);
#endif
        asm volatile("s_waitcnt vmcnt(0)" ::: "memory");
        __syncthreads();
        if (threadIdx.x == 0) {
            __builtin_amdgcn_fence(__ATOMIC_RELEASE, "agent");
            asm volatile("s_waitcnt vmcnt(0)" ::: "memory");
            (void)__hip_atomic_fetch_add(wready, 1u, __ATOMIC_RELAXED, __HIP_MEMORY_SCOPE_AGENT);
        }
        phase_xnorm(a, c);
    } else {
        phase_xnorm(a, c);
        if (threadIdx.x == 0) {
            unsigned sp = 0;
            while (__hip_atomic_load(wready, __ATOMIC_RELAXED, __HIP_MEMORY_SCOPE_AGENT) < (unsigned)c.GV) { __builtin_amdgcn_s_sleep(2); if (++sp > (1u << 22)) break; }
            __builtin_amdgcn_fence(__ATOMIC_ACQUIRE, "agent");
            asm volatile("s_waitcnt vmcnt(0)" ::: "memory");
        }
        __syncthreads();
    }
    xcd_barrier(gb);
    run_gemm<EpiProj, true>(lds, c, (const bf16_t*)(wsg + G_HN), (const bf16_t*)(ws + WS_WIN), 2048, 1024, EpiProj{(bf16_t*)(wsg + G_U3), (bf16_t*)(wsg + G_PROJ)});
    xcd_barrier(gb);
    phase_ssm(a, c, lds);
    xcd_barrier(gb);
    run_gemm(lds, c, (const bf16_t*)(wsg + G_YG), (const bf16_t*)(ws + WS_WGLU), 512, 512, EpiGlu{(const bf16_t*)(wsg + G_YG), (bf16_t*)(wsg + G_YCAT), a.in[13], (float*)(ws + WS_SS) + (size_t)c.grp * M_HALF});
    xcd_barrier(gb);
    phase_mix(a, c);
#if defined(PROBE_X2) && (PROBE_X2 & 2)
    if (c.grp == 1) phase_mix(a, c);
#endif
    xcd_barrier(gb);
    run_gemm(lds, c, (const bf16_t*)(wsg + G_YCAT), (const bf16_t*)(ws + WS_WOUT), 1024, 1024, EpiStoreBlk<0>{(bf16_t*)(wsg + G_O), 1024});
    xcd_barrier(gb);
    phase_resid6(a, c);
#if defined(PROBE_X2) && (PROBE_X2 & 2)
    if (c.grp == 1) phase_resid6(a, c);
#endif
    xcd_barrier(gb);
#ifdef PROBE_DUMMY
#pragma unroll 1
    for (int rp = 0; rp < 2; ++rp) {
        ProbeOrder S; S.init(M_HALF, 4096, c.GV, c.vb, 4); S.mode = rp;
        EpiStore<1> E{rp ? (bf16_t*)(ws + WS_END) : (bf16_t*)(wsg + G_H), 4096};
        pg8::gemm_phase<EpiStore<1>, ProbeOrder, true, true>((PG8_LAS unsigned char*)lds, pg8::Gemm{(const bf16_t*)(wsg + G_X1B), (const bf16_t*)(ws + WS_WUP), M_HALF, 4096, 1024}, S, E);
        xcd_barrier(gb);
    }
#elif defined(PROBE_UP2)
#pragma unroll 1
    for (int rp = 0; rp < (c.grp == 1 ? 2 : 1); ++rp) {
        run_gemm(lds, c, (const bf16_t*)(wsg + G_X1B), (const bf16_t*)(ws + WS_WUP), 4096, 1024, EpiStore<1>{(bf16_t*)(wsg + G_H), 4096});
        xcd_barrier(gb);
    }
#else
    run_gemm<EpiStoreBlk<1>, true>(lds, c, (const bf16_t*)(wsg + G_X1B), (const bf16_t*)(ws + WS_WUP), 4096, 1024, EpiStoreBlk<1>{(bf16_t*)(wsg + G_H), 4096});
    xcd_barrier(gb);
#endif
    run_gemm<EpiStoreBlk<0>, true>(lds, c, (const bf16_t*)(wsg + G_H), (const bf16_t*)(ws + WS_WDN), 1024, 4096, EpiStoreBlk<0>{(bf16_t*)(wsg + G_HN), 1024}, 1);
    xcd_barrier(gb);
    constexpr int NPAIR = M_HALF / 2, HELP = NPAIR / 8;
    unsigned* ddone = wready + 128;
    if (c.grp == 1 && threadIdx.x == 0) (void)__hip_atomic_fetch_add(ddone, 1u, __ATOMIC_RELAXED, __HIP_MEMORY_SCOPE_AGENT);
#pragma unroll 1
    for (int run = 0; run < (c.grp == 0 ? 2 : 1); ++run) {
        if (run == 1) {
            if (threadIdx.x == 0) {
                unsigned sp = 0;
                while (__hip_atomic_load(ddone, __ATOMIC_RELAXED, __HIP_MEMORY_SCOPE_AGENT) == 0u) { __builtin_amdgcn_s_sleep(2); if (++sp > (1u << 22)) break; }
                __builtin_amdgcn_fence(__ATOMIC_ACQUIRE, "agent");
                asm volatile("s_waitcnt vmcnt(0)" ::: "memory");
            }
            __syncthreads();
        }
        const int tg = run == 1 ? 1 : c.grp;
        const int p_lo = run == 1 ? NPAIR - HELP : 0, p_hi = (c.grp == 1) ? NPAIR - HELP : NPAIR;
        phase_final(a, c, tg, p_lo, p_hi);
    }
}

extern "C" void kernel_launch(void* const* d_in, const int* in_sizes, int n_in, void* d_out, int out_size, void* d_ws, size_t ws_size, hipStream_t stream) {
    static int grid = 0;
    if (grid == 0) {
        if (n_in != 21 || in_sizes[0] != M_TOK * DM || out_size != M_TOK * DM || ws_size < WS_END) {
            fprintf(stderr, "kernel_launch: unexpected shapes (n_in %d, in0 %d, out %d, ws %zu < %zu)\n", n_in, n_in > 0 ? in_sizes[0] : -1, out_size, ws_size, (size_t)WS_END); grid = -1; return; }
        int dev = 0, cus = 0, per_cu = 0;
        (void)hipGetDevice(&dev); (void)hipDeviceGetAttribute(&cus, hipDeviceAttributeMultiprocessorCount, dev);
        if (hipFuncSetAttribute((const void*)hymba_fwd, hipFuncAttributeMaxDynamicSharedMemorySize, LDS_BYTES) != hipSuccess) fprintf(stderr, "kernel_launch: hipFuncSetAttribute failed\n");
        if (hipOccupancyMaxActiveBlocksPerMultiprocessor(&per_cu, (const void*)hymba_fwd, 512, LDS_BYTES) != hipSuccess || per_cu < 1) { fprintf(stderr, "kernel_launch: occupancy query says %d\n", per_cu); per_cu = 1; }
        (void)hipGetLastError();
        grid = cus * per_cu;
        if (grid > 256) grid = 256;
        grid &= ~15;
        if (grid < 16) { fprintf(stderr, "kernel_launch: grid %d too small\n", grid); grid = -1; return; }
    }
    if (grid < 0) return;
    Args a{};
    for (int i = 0; i < 21; ++i) a.in[i] = (const float*)d_in[i];
    a.out = (float*)d_out; a.ws = (unsigned char*)d_ws;
    a.ph_lo = 0; a.ph_hi = N_PHASES;
    if (hipMemsetAsync((unsigned char*)d_ws + WS_BAR, 0, BAR_BYTES, stream) != hipSuccess) { fprintf(stderr, "kernel_launch: memset of the barrier words failed\n"); return; }
    void* args[] = {&a};
    hipError_t e = hipLaunchCooperativeKernel((const void*)hymba_fwd, dim3(grid), dim3(512), args, LDS_BYTES, stream);
    if (e != hipSuccess) fprintf(stderr, "kernel_launch: cooperative launch failed: %s (grid %d)\n", hipGetErrorString(e), grid);
}
```

```cpp
#define MK_MULTI 0
#include <hip/hip_runtime.h>
namespace pg8 {
#define PG8_LAS __attribute__((address_space(3)))
typedef unsigned short bf16_t;
typedef short bf16x8 __attribute__((ext_vector_type(8)));
typedef float f32x4 __attribute__((ext_vector_type(4)));
typedef unsigned u32x4 __attribute__((ext_vector_type(4)));
constexpr int BM = 256, BK = 64, HALF = 128, HTB = HALF * BK * 2  , STAGE_BYTES = 8 * HTB, NXCD = 8, WGM = 8;

__host__ __device__ __forceinline__ int lds_byte(int r, int c) { const int st = (r >> 4) * 2 + (c >> 5), rr = r & 15, cc = c & 31, ob = rr * 64 + cc * 2; return st * 1024 + (ob ^ (((ob >> 9) & 1) << 5)); }
__host__ __device__ __forceinline__ void stage_rc(int b, int& R, int& C) { const int st = b / 1024, sb = b % 1024, swz = sb ^ (((sb >> 9) & 1) << 5); R = (st >> 1) * 16 + swz / 64; C = (st & 1) * 32 + (swz % 64) / 2; }
__host__ __device__ __forceinline__ int perm32(int rho) { const int n = rho >> 4, i = rho & 15; return 8 * (i >> 2) + 4 * n + (i & 3); }

struct Unit { int pm, pn; };
struct Gemm { const bf16_t* A; const bf16_t* Bt; int M, N, K; };

struct StaticOrder {
    int nM, nN, nwg, G, c, nx, rev;
    __host__ __device__ void init(int M, int N, int G_, int c_, int nx_ = NXCD, int rev_ = 0) { nM = M / BM; nN = N / BM; nwg = nM * nN; G = G_; c = c_; nx = nx_; rev = (rev_ && nwg % G_ == 0) ? 1 : 0; }
    __host__ __device__ bool next(int i, Unit& u) const {
        const long L = (long)(rev ? (nwg / G - 1 - i) : i) * G + c; if (L >= nwg || L < 0) return false;
        int wgid = (int)L; { const int q = nwg / nx, r = nwg % nx, xcd = wgid % nx, off = wgid / nx; wgid = (xcd < r ? xcd * (q + 1) : r * (q + 1) + (xcd - r) * q) + off; }
        const int nig = WGM * nN, gid = wgid / nig, fm = gid * WGM, gsz = (nM - fm) < WGM ? (nM - fm) : WGM;
        u.pm = fm + ((wgid % nig) % gsz); u.pn = (wgid % nig) / gsz; return true;
    }
    __device__ __forceinline__ void a_ready(const Unit&) const {}
    __device__ __forceinline__ void done(const Unit&) const {}
};
__device__ __forceinline__ unsigned cvt_pk_bf16(float lo, float hi) { unsigned r; asm("v_cvt_pk_bf16_f32 %0, %1, %2" : "=v"(r) : "v"(lo), "v"(hi)); return r; }
template <class Epi, class Sched, bool ALIGN_EPI = false, bool SP2 = false, bool ABLK = false>
__device__ __forceinline__ void gemm_phase(PG8_LAS unsigned char* lds, const Gemm g, const Sched& S, const Epi& E) {
    const int tid = threadIdx.x, wid = __builtin_amdgcn_readfirstlane(tid >> 6), lane = tid & 63, wr = wid >> 2, wc = wid & 3, fr = lane & 15, fq = lane >> 4;
    const int K = g.K, nt = K / BK;
    unsigned voffA[2], voffB[2];
#pragma unroll
    for (int i = 0; i < 2; ++i) { int R, C; stage_rc(tid * 16 + i * 8192, R, C); const int Rb = Epi::PERM ? ((R & ~31) + perm32(R & 31)) : R;
        voffA[i] = ABLK ? (unsigned)(((((R >> 4) * (K >> 5) + (C >> 5)) * 16 + (R & 15)) * 32 + (C & 31))) * 2u : (unsigned)(R * K + C) * 2u; voffB[i] = (unsigned)(Rb * K + C) * 2u; }
    const size_t kstep = (size_t)(BK * 2);
    const size_t kstepA = ABLK ? (size_t)2048 : kstep;
    const size_t hstep = (size_t)HALF * K * 2;
    const size_t tstep = 2 * hstep;
    const unsigned ldsw = (unsigned)wid * 1024u;
    const int aoff = lds_byte(wr * 64 + fr, fq * 8), boff = lds_byte(wc * 32 + fr, fq * 8);
#define PG8_SA(b, h) (((b) * 2 + (h)) * HTB)
#define PG8_SB(b, h) ((4 + (b) * 2 + (h)) * HTB)
#define PG8_STAGE(bufoff, gbase, voff) do { _Pragma("unroll") for (int _i = 0; _i < 2; ++_i) \
        __builtin_amdgcn_global_load_lds((const unsigned*)((const char*)(gbase) + (voff)[_i]), (PG8_LAS unsigned*)(lds + (bufoff) + ldsw + _i * 8192), 16, 0, 0); } while (0)
#define PG8_LDA(dst, b, h) do { _Pragma("unroll") for (int m = 0; m < 4; ++m) _Pragma("unroll") for (int k = 0; k < 2; ++k) dst[m][k] = *(const PG8_LAS bf16x8*)(lds + PG8_SA(b, h) + aoff + m * 2048 + k * 1024); } while (0)
#define PG8_LDB(dst, b, h) do { _Pragma("unroll") for (int n = 0; n < 2; ++n) _Pragma("unroll") for (int k = 0; k < 2; ++k) dst[n][k] = *(const PG8_LAS bf16x8*)(lds + PG8_SB(b, h) + boff + n * 2048 + k * 1024); } while (0)
#define PG8_MMA(ai, bj, At, Bt) do { __builtin_amdgcn_s_setprio(1); _Pragma("unroll") for (int m = 0; m < 4; ++m) _Pragma("unroll") for (int n = 0; n < 2; ++n) _Pragma("unroll") for (int k = 0; k < 2; ++k) \
        acc[ai][bj][m][n] = __builtin_amdgcn_mfma_f32_16x16x32_bf16(Bt[n][k], At[m][k], acc[ai][bj][m][n], 0, 0, 0); __builtin_amdgcn_s_setprio(0); } while (0)
#define PG8_MMAQ(ai, bj, At, Bt) do { _Pragma("unroll") for (int m = 0; m < 4; ++m) _Pragma("unroll") for (int n = 0; n < 2; ++n) _Pragma("unroll") for (int k = 0; k < 2; ++k) \
        acc[ai][bj][m][n] = __builtin_amdgcn_mfma_f32_16x16x32_bf16(Bt[n][k], At[m][k], acc[ai][bj][m][n], 0, 0, 0); } while (0)
#define PG8_WAIT_V(n) asm volatile("s_waitcnt vmcnt(" #n ")" ::: "memory")
#define PG8_WAIT_L(n) asm volatile("s_waitcnt lgkmcnt(" #n ")" ::: "memory")
#define PG8_BAR __builtin_amdgcn_s_barrier()
#define PG8_SCHED __builtin_amdgcn_sched_barrier(0)
    Unit cur, nxt; int ui = 0;
    if (!S.next(0, cur)) return;
    f32x4 acc[2][2][4][2];
#pragma unroll
    for (int a = 0; a < 2; ++a)
#pragma unroll
        for (int b = 0; b < 2; ++b)
#pragma unroll
            for (int m = 0; m < 4; ++m)
#pragma unroll
                for (int n = 0; n < 2; ++n) acc[a][b][m][n] = (f32x4){0.f, 0.f, 0.f, 0.f};
    bf16x8 At[4][2], B0[2][2], B1[2][2];
    const char* cA = (const char*)g.A + (size_t)cur.pm * tstep; const char* cB = (const char*)g.Bt + (size_t)cur.pn * tstep;
    S.a_ready(cur);
    if constexpr (SP2) {
        PG8_STAGE(PG8_SB(0, 0), cB, voffB); PG8_STAGE(PG8_SB(0, 1), cB + hstep, voffB); PG8_STAGE(PG8_SA(0, 0), cA, voffA); PG8_STAGE(PG8_SA(0, 1), cA + hstep, voffA);
        if (wr == 1) PG8_BAR;
        PG8_WAIT_V(2); PG8_BAR;
        PG8_STAGE(PG8_SB(1, 0), cB + kstep, voffB); PG8_STAGE(PG8_SA(1, 0), cA + kstepA, voffA); PG8_STAGE(PG8_SB(1, 1), cB + hstep + kstep, voffB);
        PG8_WAIT_V(6); PG8_BAR;
    } else {
        PG8_STAGE(PG8_SB(0, 0), cB, voffB); PG8_STAGE(PG8_SA(0, 0), cA, voffA); PG8_STAGE(PG8_SB(0, 1), cB + hstep, voffB); PG8_STAGE(PG8_SA(0, 1), cA + hstep, voffA);
        if (wr == 1) PG8_BAR;
        PG8_WAIT_V(4); PG8_BAR;
        PG8_STAGE(PG8_SB(1, 0), cB + kstep, voffB); PG8_STAGE(PG8_SA(1, 0), cA + kstepA, voffA); PG8_STAGE(PG8_SB(1, 1), cB + hstep + kstep, voffB);
        PG8_WAIT_V(6); PG8_BAR;
    }
    for (;;) {
        const bool has_next = S.next(ui + 1, nxt);
        const char* nA = has_next ? (const char*)g.A + (size_t)nxt.pm * tstep : cA; const char* nB = has_next ? (const char*)g.Bt + (size_t)nxt.pn * tstep : cB;
        for (int t = 0; t < nt; t += 2) {
            const bool last = (t == nt - 2);
            const char* a1 = cA + (size_t)(t + 1) * kstepA;
            const char* a2 = last ? nA : cA + (size_t)(t + 2) * kstepA; const char* b2 = last ? nB : cB + (size_t)(t + 2) * kstep;
            const char* a3 = a2 + kstepA; const char* b3 = b2 + kstep;
            if (last && has_next) S.a_ready(nxt);
            if constexpr (SP2) {
            PG8_LDB(B0, 0, 0); PG8_LDB(B1, 0, 1); PG8_SCHED; PG8_LDA(At, 0, 0); PG8_STAGE(PG8_SA(1, 1), a1 + hstep, voffA);
            PG8_WAIT_V(8); PG8_WAIT_L(0); PG8_BAR; __builtin_amdgcn_s_setprio(1); PG8_MMAQ(0, 0, At, B0); PG8_MMAQ(0, 1, At, B1); __builtin_amdgcn_s_setprio(0); PG8_BAR; PG8_SCHED;
            PG8_LDA(At, 0, 1); PG8_STAGE(PG8_SB(0, 0), b2, voffB); PG8_STAGE(PG8_SB(0, 1), b2 + hstep, voffB); PG8_STAGE(PG8_SA(0, 0), a2, voffA);
            PG8_WAIT_V(8); PG8_WAIT_L(0); PG8_BAR; __builtin_amdgcn_s_setprio(1); PG8_MMAQ(1, 0, At, B0); PG8_MMAQ(1, 1, At, B1); __builtin_amdgcn_s_setprio(0); PG8_BAR; PG8_SCHED;
            PG8_LDB(B0, 1, 0); PG8_LDB(B1, 1, 1); PG8_SCHED; PG8_LDA(At, 1, 0); PG8_STAGE(PG8_SA(0, 1), a2 + hstep, voffA);
            PG8_WAIT_V(8); PG8_WAIT_L(0); PG8_BAR; __builtin_amdgcn_s_setprio(1); PG8_MMAQ(0, 0, At, B0); PG8_MMAQ(0, 1, At, B1); __builtin_amdgcn_s_setprio(0); PG8_BAR; PG8_SCHED;
            PG8_LDA(At, 1, 1); PG8_STAGE(PG8_SB(1, 0), b3, voffB); PG8_STAGE(PG8_SB(1, 1), b3 + hstep, voffB); PG8_STAGE(PG8_SA(1, 0), a3, voffA);
            PG8_WAIT_V(8); PG8_WAIT_L(0); PG8_BAR; __builtin_amdgcn_s_setprio(1); PG8_MMAQ(1, 0, At, B0); PG8_MMAQ(1, 1, At, B1); __builtin_amdgcn_s_setprio(0); PG8_BAR; PG8_SCHED;
            } else {
            PG8_LDB(B0, 0, 0); PG8_SCHED; PG8_LDA(At, 0, 0); PG8_STAGE(PG8_SA(1, 1), a1 + hstep, voffA);
            PG8_WAIT_L(8); PG8_BAR; PG8_WAIT_L(0); PG8_MMA(0, 0, At, B0); PG8_BAR; PG8_SCHED;
            PG8_LDB(B1, 0, 1); PG8_STAGE(PG8_SB(0, 0), b2, voffB);
            PG8_BAR; PG8_WAIT_L(0); PG8_MMA(0, 1, At, B1); PG8_BAR;
            PG8_LDA(At, 0, 1); PG8_STAGE(PG8_SA(0, 0), a2, voffA);
            PG8_BAR; PG8_WAIT_L(0); PG8_MMA(1, 0, At, B0); PG8_BAR; PG8_SCHED;
            PG8_STAGE(PG8_SB(0, 1), b2 + hstep, voffB);
            PG8_WAIT_V(6); PG8_BAR; PG8_MMA(1, 1, At, B1); PG8_BAR;
            PG8_LDB(B0, 1, 0); PG8_SCHED; PG8_LDA(At, 1, 0); PG8_STAGE(PG8_SA(0, 1), a2 + hstep, voffA);
            PG8_WAIT_L(8); PG8_BAR; PG8_WAIT_L(0); PG8_MMA(0, 0, At, B0); PG8_BAR; PG8_SCHED;
            PG8_LDB(B1, 1, 1); PG8_STAGE(PG8_SB(1, 0), b3, voffB);
            PG8_BAR; PG8_WAIT_L(0); PG8_MMA(0, 1, At, B1); PG8_BAR;
            PG8_LDA(At, 1, 1); PG8_STAGE(PG8_SA(1, 0), a3, voffA);
            PG8_BAR; PG8_WAIT_L(0); PG8_MMA(1, 0, At, B0); PG8_BAR; PG8_SCHED;
            PG8_STAGE(PG8_SB(1, 1), b3 + hstep, voffB);
            PG8_WAIT_V(6); PG8_BAR; PG8_MMA(1, 1, At, B1); PG8_BAR;
            }
        }
        if constexpr (ALIGN_EPI) { if (wr == 0) PG8_BAR; }
        if constexpr (!Epi::AFTER_DRAIN) { E(acc, cur, wr, wc, fr, fq); S.done(cur); }
        if (!has_next) break;
#pragma unroll
        for (int a = 0; a < 2; ++a)
#pragma unroll
            for (int b = 0; b < 2; ++b)
#pragma unroll
                for (int m = 0; m < 4; ++m)
#pragma unroll
                    for (int n = 0; n < 2; ++n) acc[a][b][m][n] = (f32x4){0.f, 0.f, 0.f, 0.f};
        cur = nxt; cA = nA; cB = nB; ++ui;
        if constexpr (ALIGN_EPI) { if (wr == 1) PG8_BAR; }
    }
    PG8_WAIT_V(0);
    if constexpr (!ALIGN_EPI) { if (wr == 0) PG8_BAR; }
    PG8_BAR;
    if constexpr (Epi::AFTER_DRAIN) { E.fused(acc, cur, wr, wc, fr, fq, lds, wid, lane); S.done(cur); }
#undef PG8_SA
#undef PG8_SB
#undef PG8_STAGE
#undef PG8_LDA
#undef PG8_LDB
#undef PG8_MMA
#undef PG8_MMAQ
#undef PG8_WAIT_V
#undef PG8_WAIT_L
#undef PG8_BAR
#undef PG8_SCHED
}
}

#include <hip/hip_cooperative_groups.h>
#include <cstdio>
#include <cstdint>
namespace cg = cooperative_groups;
using pg8::bf16_t; using pg8::bf16x8; using pg8::f32x4; using pg8::u32x4; using pg8::cvt_pk_bf16;
typedef unsigned u32;
typedef u32 u32x2 __attribute__((ext_vector_type(2)));
typedef float f32x16 __attribute__((ext_vector_type(16)));
typedef float f32x2_t __attribute__((ext_vector_type(2)));

#ifndef MK_MULTI
#define MK_MULTI 0
#endif
#define LAS __attribute__((address_space(3)))
#define XB_TMO      128
#define XB_XCNT(j)  (256  + 64 * (j))
#define XB_XSUB(j)  (1280 + 64 * (j))
#define XB_XGEN(j)  (2304 + 64 * (j))
#define XB_TOP      3328
#define XB_TOPGEN   3392
#define XCD_BAR_WORDS 3456
#define XB_SPIN_CAP (1u << 18)

__device__ __forceinline__ unsigned xb_ld(unsigned* p)              { return __hip_atomic_load(p, __ATOMIC_RELAXED, __HIP_MEMORY_SCOPE_AGENT); }
__device__ __forceinline__ unsigned xb_add(unsigned* p, unsigned v) { return __hip_atomic_fetch_add(p, v, __ATOMIC_RELAXED, __HIP_MEMORY_SCOPE_AGENT); }
__device__ __forceinline__ unsigned xb_xcc_id() { return (unsigned)__builtin_amdgcn_s_getreg((3 << 11) | 20) & 0xFu; }
#define XB_SPIN(cond, bar) do { unsigned _sp = 0; while (cond) { __builtin_amdgcn_s_sleep(1); \
    if ((++_sp & 255u) == 0u) { if (xb_ld(&(bar)[XB_TMO])) break; if (_sp > XB_SPIN_CAP) { atomicAdd(&(bar)[XB_TMO], 1u); break; } } } } while (0)

struct XcdBarrier {
    unsigned* bar; unsigned x; unsigned G;
    volatile LAS unsigned* st;
};

__device__ __forceinline__ XcdBarrier xcd_barrier_post(unsigned* bar, volatile LAS unsigned* st, unsigned G) {
    XcdBarrier b; b.bar = bar; b.x = xb_xcc_id(); b.st = st; b.G = G;
    if (threadIdx.x == 0) (void)xb_add(&bar[XB_XCNT(b.x)], 1u);
    return b;
}
__device__ __forceinline__ void xcd_barrier_complete(unsigned* bar, unsigned x, const unsigned G, unsigned& nloc, unsigned& nx) {
    unsigned sum, cnt, mine, sp = 0u;
    for (;;) {
        sum = 0u; cnt = 0u; mine = 0u;
#pragma unroll
        for (unsigned j = 0; j < 16; ++j) { const unsigned c = xb_ld(&bar[XB_XCNT(j)]); sum += c; cnt += (c > 0u) ? 1u : 0u; mine = (j == x) ? c : mine; }
        if (sum == G) break;
        __builtin_amdgcn_s_sleep(1);
        if ((++sp & 255u) == 0u) { if (xb_ld(&bar[XB_TMO])) break; if (sp > XB_SPIN_CAP) { atomicAdd(&bar[XB_TMO], 1u); break; } }
    }
    nloc = mine > 0u ? mine : 1u; nx = cnt > 0u ? cnt : 1u;
}

__device__ __forceinline__ void xcd_barrier(const XcdBarrier& b) {
    asm volatile("s_waitcnt vmcnt(0)" ::: "memory");
    __syncthreads();
    if (threadIdx.x == 0) {
        unsigned* bar = b.bar;
        __builtin_amdgcn_s_waitcnt(0);
        unsigned nloc = b.st[0], nx = b.st[1];
        if (nloc == 0u) { xcd_barrier_complete(bar, b.x, b.G, nloc, nx); b.st[0] = nloc; b.st[1] = nx; }
        const unsigned old = xb_add(&bar[XB_XSUB(b.x)], 1u);
        const unsigned gen = old / nloc;
        if (old + 1u == (gen + 1u) * nloc) {
            __builtin_amdgcn_fence(__ATOMIC_RELEASE, "agent");
            asm volatile("s_waitcnt vmcnt(0)" ::: "memory");
            const unsigned og = xb_add(&bar[XB_TOP], 1u);
            const unsigned tg = og / nx;
            if (og + 1u == (tg + 1u) * nx) xb_add(&bar[XB_TOPGEN], 1u);
            else XB_SPIN(xb_ld(&bar[XB_TOPGEN]) == tg, bar);
            __builtin_amdgcn_fence(__ATOMIC_ACQUIRE, "agent");
            xb_add(&bar[XB_XGEN(b.x)], 1u);
            asm volatile("s_waitcnt vmcnt(0)" ::: "memory");
        } else {
            XB_SPIN(xb_ld(&bar[XB_XGEN(b.x)]) == gen, bar);
            __builtin_amdgcn_fence(__ATOMIC_ACQUIRE, "agent");
            asm volatile("s_waitcnt vmcnt(0)" ::: "memory");
        }
    }
    __syncthreads();
}


constexpr int M_TOK = 65536, DM = 1024, SEQ = 8192;
constexpr int N_PHASES = 10;
constexpr int LDS_BYTES = 147456;
constexpr float RMS_EPS = 1e-6f;

constexpr size_t MiB = 1024ull * 1024ull;
constexpr size_t WS_WIN = 0, WS_WGLU = 4 * MiB, WS_WOUT = 5 * MiB, WS_WUP = 8 * MiB, WS_WDN = 16 * MiB;
constexpr size_t WS_TWST = 24 * MiB, WS_TWOUT = 26 * MiB, WS_TKT = 28 * MiB, WS_TSC = 29 * MiB, WS_BAR = 30 * MiB;
constexpr size_t WS_SS = 31 * MiB;
constexpr size_t WS_RINV = 31 * MiB + 512 * 1024;
constexpr size_t BAR_STRIDE = 16384, BAR_BYTES = 3 * BAR_STRIDE;
constexpr int LDS_ST_OFF = 147440;
constexpr size_t WS_GROUP0 = 32 * MiB, GROUP_BYTES = 464 * MiB;
constexpr size_t G_X1B = 0  , G_SWS = 0, G_CWS = 32 * MiB, G_U3 = 48 * MiB, G_HN = 80 * MiB, G_O = 144 * MiB, G_BIG = 208 * MiB;
constexpr size_t G_PROJ = G_BIG, G_YG = G_BIG + 96 * MiB, G_YGLU = G_BIG + 128 * MiB, G_YCAT = G_BIG + 160 * MiB, G_H = G_BIG;
constexpr size_t WS_END = WS_GROUP0 + 2 * GROUP_BYTES;
constexpr int KT_ELEMS = 17 * 256, KT_PLANE = 17 * 128;
constexpr int M_HALF = M_TOK / 2;

struct Ctx { int grp, vb, GV, m0; unsigned char* wsg; };

struct Args { const float* in[21]; float* out; unsigned char* ws; int ph_lo, ph_hi; };

__device__ __forceinline__ float bf_lo(u32 w) { return __uint_as_float(w << 16); }
__device__ __forceinline__ float bf_hi(u32 w) { return __uint_as_float(w & 0xffff0000u); }
__device__ __forceinline__ bf16_t f2bf(float f) { return (bf16_t)(cvt_pk_bf16(f, 0.f) & 0xffffu); }
__device__ __forceinline__ float wave_sum(float v) {
#pragma unroll
    for (int o = 1; o < 64; o <<= 1) v += __shfl_xor(v, o);
    return v;
}
__device__ __forceinline__ float fast_rcp(float x) { return __builtin_amdgcn_rcpf(x); }
__device__ __forceinline__ float sigmoidf_(float v) { return fast_rcp(1.f + __expf(-v)); }
__device__ __forceinline__ float gelu_tanh(float v) {
    const float t = v * (-2.3022082f + -0.10294324f * (v * v)); return v * fast_rcp(1.f + __builtin_amdgcn_exp2f(t)); }

struct EpiProj {
    static constexpr bool PERM = true, AFTER_DRAIN = false;
    bf16_t* U3; bf16_t* P;
    __device__ __forceinline__ void operator()(const f32x4 (&acc)[2][2][4][2], const pg8::Unit& u, int wr, int wc, int fr, int fq) const {
        const int row0 = u.pm * 256 + wr * 64 + fr, colb = u.pn * 256 + wc * 32 + 8 * fq;
#pragma unroll
        for (int ai = 0; ai < 2; ++ai)
#pragma unroll
            for (int m = 0; m < 4; ++m) {
                const int row = row0 + ai * 128 + m * 16;
                if (u.pn >= 2 && u.pn < 6) {
                    const f32x4 h0 = acc[ai][0][m][0], c0 = acc[ai][0][m][1], h1 = acc[ai][1][m][0], c1 = acc[ai][1][m][1];
                    u32x4 z; z.x = cvt_pk_bf16(h0[0] * c0[0], h0[1] * c0[1]); z.y = cvt_pk_bf16(h0[2] * c0[2], h0[3] * c0[3]); z.z = cvt_pk_bf16(h1[0] * c1[0], h1[1] * c1[1]); z.w = cvt_pk_bf16(h1[2] * c1[2], h1[3] * c1[3]);
                    *(u32x4*)(P + (size_t)row * 1024 + (u.pn - 2) * 128 + wc * 32 + 8 * fq) = z;
                } else {
#pragma unroll
                    for (int bj = 0; bj < 2; ++bj) {
                        const int col = colb + bj * 128;
                        const f32x4 v0 = acc[ai][bj][m][0], v1 = acc[ai][bj][m][1];
                        u32x4 w; w.x = cvt_pk_bf16(v0[0], v0[1]); w.y = cvt_pk_bf16(v0[2], v0[3]); w.z = cvt_pk_bf16(v1[0], v1[1]); w.w = cvt_pk_bf16(v1[2], v1[3]);
                        if (u.pn < 2) {
                            const int b = row >> 13, tl = row & 8191, g = col >> 4, hf = (col >> 3) & 1;
                            const size_t off = (((size_t)(b * 32 + g) * 8192 + tl) * 2 + hf) * 8;
                            *(u32x4*)(U3 + off) = w;
                        } else {
                            *(u32x4*)(P + (size_t)row * 1024 + 512 + (col - 1536)) = w;
                        }
                    }
                }
            }
    }
};
template <int ACT  > struct EpiStore {
    static constexpr bool PERM = true, AFTER_DRAIN = false;
    bf16_t* O; int ldc;
    __device__ __forceinline__ void operator()(const f32x4 (&acc)[2][2][4][2], const pg8::Unit& u, int wr, int wc, int fr, int fq) const {
        const int row0 = u.pm * 256 + wr * 64 + fr, colb = u.pn * 256 + wc * 32 + 8 * fq;
#pragma unroll
        for (int ai = 0; ai < 2; ++ai)
#pragma unroll
            for (int m = 0; m < 4; ++m) {
                bf16_t* rowp = O + (size_t)(row0 + ai * 128 + m * 16) * ldc + colb;
#pragma unroll
                for (int bj = 0; bj < 2; ++bj) {
                    f32x4 v0 = acc[ai][bj][m][0], v1 = acc[ai][bj][m][1];
                    if (ACT == 1) {
#pragma unroll
                        for (int j = 0; j < 4; ++j) {
                            float a0, a1; asm("v_max_f32 %0, 0, %1" : "=v"(a0) : "v"(v0[j])); asm("v_max_f32 %0, 0, %1" : "=v"(a1) : "v"(v1[j]));
                            f32x2_t p = (f32x2_t){a0, a1}; p = p * p; v0[j] = p.x; v1[j] = p.y; }
                    }
                    u32x4 w; w.x = cvt_pk_bf16(v0[0], v0[1]); w.y = cvt_pk_bf16(v0[2], v0[3]); w.z = cvt_pk_bf16(v1[0], v1[1]); w.w = cvt_pk_bf16(v1[2], v1[3]);
                    *(u32x4*)(rowp + bj * 128) = w;
                }
            }
    }
};
template <int ACT  > struct EpiStoreBlk {
    static constexpr bool PERM = true, AFTER_DRAIN = false;
    bf16_t* O; int ldc;
    __device__ __forceinline__ void operator()(const f32x4 (&acc)[2][2][4][2], const pg8::Unit& u, int wr, int wc, int fr, int fq) const {
        const int rb0 = u.pm * 16 + wr * 4, cb0 = u.pn * 8 + wc, cbs = ldc >> 5;
#pragma unroll
        for (int ai = 0; ai < 2; ++ai)
#pragma unroll
            for (int m = 0; m < 4; ++m) {
#pragma unroll
                for (int bj = 0; bj < 2; ++bj) {
                    f32x4 v0 = acc[ai][bj][m][0], v1 = acc[ai][bj][m][1];
                    if (ACT == 1) {
#pragma unroll
                        for (int j = 0; j < 4; ++j) {
                            float a0, a1; asm("v_max_f32 %0, 0, %1" : "=v"(a0) : "v"(v0[j])); asm("v_max_f32 %0, 0, %1" : "=v"(a1) : "v"(v1[j]));
                            f32x2_t p = (f32x2_t){a0, a1}; p = p * p; v0[j] = p.x; v1[j] = p.y; }
                    }
                    u32x4 w; w.x = cvt_pk_bf16(v0[0], v0[1]); w.y = cvt_pk_bf16(v0[2], v0[3]); w.z = cvt_pk_bf16(v1[0], v1[1]); w.w = cvt_pk_bf16(v1[2], v1[3]);
                    const size_t off = (((size_t)(rb0 + ai * 8 + m) * cbs + (cb0 + bj * 4)) * 16 + fr) * 32 + 8 * fq;
                    *(u32x4*)(O + off) = w;
                }
            }
    }
};
struct EpiGlu {
    static constexpr bool PERM = true, AFTER_DRAIN = false;
    const bf16_t* Y; bf16_t* O; const float* gs; float* SS;
    __device__ __forceinline__ void operator()(const f32x4 (&acc)[2][2][4][2], const pg8::Unit& u, int wr, int wc, int fr, int fq) const {
        const int row0 = u.pm * 256 + wr * 64 + fr, colb = u.pn * 256 + wc * 32 + 8 * fq;
        f32x4 g[2][2];
#pragma unroll
        for (int bj = 0; bj < 2; ++bj) { g[bj][0] = *(const f32x4*)(gs + colb + bj * 128); g[bj][1] = *(const f32x4*)(gs + colb + bj * 128 + 4); }
#pragma unroll
        for (int ai = 0; ai < 2; ++ai)
#pragma unroll
            for (int m = 0; m < 4; ++m) {
                const int row = row0 + ai * 128 + m * 16;
                float ss = 0.f;
#pragma unroll
                for (int bj = 0; bj < 2; ++bj) {
                    const f32x4 v0 = acc[ai][bj][m][0], v1 = acc[ai][bj][m][1];
                    const u32x4 y = *(const u32x4*)(Y + (size_t)row * 512 + colb + bj * 128);
                    f32x4 t0, t1;
                    t0[0] = bf_lo(y.x) * sigmoidf_(v0[0]); t0[1] = bf_hi(y.x) * sigmoidf_(v0[1]); t0[2] = bf_lo(y.y) * sigmoidf_(v0[2]); t0[3] = bf_hi(y.y) * sigmoidf_(v0[3]);
                    t1[0] = bf_lo(y.z) * sigmoidf_(v1[0]); t1[1] = bf_hi(y.z) * sigmoidf_(v1[1]); t1[2] = bf_lo(y.w) * sigmoidf_(v1[2]); t1[3] = bf_hi(y.w) * sigmoidf_(v1[3]);
                    ss += (t0[0] * t0[0] + t0[1] * t0[1]) + (t0[2] * t0[2] + t0[3] * t0[3]) + (t1[0] * t1[0] + t1[1] * t1[1]) + (t1[2] * t1[2] + t1[3] * t1[3]);
                    t0 = t0 * g[bj][0]; t1 = t1 * g[bj][1];
                    u32x4 w; w.x = cvt_pk_bf16(t0[0], t0[1]); w.y = cvt_pk_bf16(t0[2], t0[3]); w.z = cvt_pk_bf16(t1[0], t1[1]); w.w = cvt_pk_bf16(t1[2], t1[3]);
                    *(u32x4*)(O + (size_t)row * 1024 + colb + bj * 128) = w;
                }
                ss += __shfl_xor(ss, 16); ss += __shfl_xor(ss, 32);
                if (fq == 0) unsafeAtomicAdd(SS + row, ss);
            }
    }
};

__device__ __forceinline__ void cpowd(double lrdt, double lidt, double k, float& re, float& im) {
    const double mag = exp(lrdt * k);
    double ang = lidt * k;
    ang -= 6.283185307179586476925 * rint(ang * 0.15915494309189533577);
    re = (float)(mag * cos(ang)); im = (float)(mag * sin(ang));
}
__device__ __forceinline__ void transpose_item(const float* W, int K, int N, bf16_t* WT, float* scr, int item, int lane, const float* gk = nullptr, bool win_map = false) {
    const int nblk = N / 32, kb = item / nblk, nb = item % nblk, k0 = 64 * kb, n0 = 32 * nb;
#pragma unroll 8
    for (int i = 0; i < 32; ++i) { const int kk = 2 * i + (lane >> 5); float w = W[(size_t)(k0 + kk) * N + n0 + (lane & 31)]; if (gk) w *= gk[k0 + kk]; scr[kk * 33 + (lane & 31)] = w; }
    __builtin_amdgcn_s_waitcnt(0xc07f); asm volatile("" ::: "memory");
    const int c = lane & 7;
#pragma unroll
    for (int j = 0; j < 4; ++j) { const int n = (lane >> 3) + 8 * j; const float* s = scr + (8 * c) * 33 + n;
        u32x4 o; o.x = cvt_pk_bf16(s[0 * 33], s[1 * 33]); o.y = cvt_pk_bf16(s[2 * 33], s[3 * 33]); o.z = cvt_pk_bf16(s[4 * 33], s[5 * 33]); o.w = cvt_pk_bf16(s[6 * 33], s[7 * 33]);
        int nr = n0 + n;
        if (win_map && nr >= 512) {
            if (nr < 1024 || nr >= 1536) { const int nn = nr >= 1536, ch = nr - (nn ? 1536 : 512), r = ch & 127;
                nr = 512 + 256 * (ch >> 7) + 128 * ((r >> 2) & 1) + 32 * (r >> 5) + 8 * ((r >> 3) & 3) + 4 * nn + (r & 3); }
            else nr = nr + 512;
        }
        *(u32x4*)(WT + (size_t)nr * K + k0 + 8 * c) = o; }
    __builtin_amdgcn_s_waitcnt(0xc07f); asm volatile("" ::: "memory");
}
__device__ __forceinline__ void phase_prep_w(const Args& a, const Ctx& c, unsigned char* lds) {
    const int tid = threadIdx.x, lane = tid & 63, wave = tid >> 6;
    const int gw = c.vb * 8 + wave, NGW = c.GV * 8;
    unsigned char* ws = a.ws;
    {
        const float* lam_re = a.in[3]; const float* lam_im = a.in[4]; const float* log_dt = a.in[5];
        const float* b_re = a.in[6]; const float* b_im = a.in[7]; const float* c_re = a.in[8]; const float* c_im = a.in[9]; const float* d_skip = a.in[10];
        float2* shpow = (float2*)(lds + 69632);
        float2* shcoef = (float2*)(lds + 69632 + 6144);
        float2* shB = (float2*)(lds + 69632 + 8192);
        float2* shC = (float2*)(lds + 69632 + 16384);
        bf16_t* TWST = (bf16_t*)(ws + WS_TWST); bf16_t* TWOUT = (bf16_t*)(ws + WS_TWOUT); bf16_t* TKT = (bf16_t*)(ws + WS_TKT); float4* TSC = (float4*)(ws + WS_TSC);
        for (int it = c.vb; it < 128; it += c.GV) {
            const int g = it >> 2, jq = it & 3;
            if (tid < 256) {
                const int p = tid & 63, jj = tid >> 6, j = 4 * jq + jj;
                const double dt = exp((double)log_dt[g]);
                const double lr = (double)lam_re[g * 64 + p], li = (double)lam_im[g * 64 + p];
                const double lrdt = lr * dt, lidt = li * dt;
                const double mag = exp(lrdt); double ang = lidt; ang -= 6.283185307179586476925 * rint(ang * 0.15915494309189533577);
                const double a1r = mag * cos(ang), a1i = mag * sin(ang);
                double pjr = 1.0, pji = 0.0, pqr = 1.0, pqi = 0.0;
                for (int k = 0; k < j; ++k) { const double t = pjr * a1r - pji * a1i; pji = pjr * a1i + pji * a1r; pjr = t; }
                for (int k = 0; k < 15 - j; ++k) { const double t = pqr * a1r - pqi * a1i; pqi = pqr * a1i + pqi * a1r; pqr = t; }
                const double p1r = pjr * a1r - pji * a1i, p1i = pjr * a1i + pji * a1r;
                shpow[(jj * 3 + 0) * 64 + p] = make_float2((float)pjr, (float)pji); shpow[(jj * 3 + 1) * 64 + p] = make_float2((float)pqr, (float)pqi); shpow[(jj * 3 + 2) * 64 + p] = make_float2((float)p1r, (float)p1i);
                if (jj == 0) {
                    const double nr = a1r - 1.0, ni = a1i, den = lr * lr + li * li;
                    shcoef[p] = make_float2((float)((nr * lr + ni * li) / den), (float)((ni * lr - nr * li) / den));
                    if (jq == 0) {
                        const double s16r = p1r * pqr - p1i * pqi, s16i = p1r * pqi + p1i * pqr;
                        double br = s16r, bi = s16i;
#pragma unroll
                        for (int k = 0; k < 6; ++k) { const double t = br * br - bi * bi; bi = 2.0 * br * bi; br = t; }
                        TSC[g * 64 + p] = make_float4((float)s16r, (float)s16i, (float)br, (float)bi);
                    }
                }
            }
            __syncthreads();
#pragma unroll
            for (int i = 0; i < 2; ++i) {
                const int e = tid + 512 * i;
                { const int p = e >> 4; const float2 co = shcoef[p]; const float br = b_re[g * 1024 + e], bi = b_im[g * 1024 + e]; shB[e] = make_float2(co.x * br - co.y * bi, co.x * bi + co.y * br); }
                shC[e] = make_float2(c_re[g * 1024 + e], c_im[g * 1024 + e]);
            }
            __syncthreads();
#pragma unroll
            for (int i = 0; i < 2; ++i) {
                const int e = tid + 512 * i, jj = e >> 8, hp = (e >> 4) & 15, h = e & 15, j = 4 * jq + jj; float val = 0.f;
#pragma unroll 8
                for (int p = 0; p < 64; ++p) {
                    const float2 A = shpow[(jj * 3 + 0) * 64 + p], bb = shB[p * 16 + h], cc = shC[hp * 64 + p];
                    const float tr = A.x * bb.x - A.y * bb.y, ti = A.x * bb.y + A.y * bb.x;
                    val += cc.x * tr - cc.y * ti;
                }
                if (j == 0 && hp == h) val += d_skip[g * 16 + hp];
                TKT[(size_t)g * KT_ELEMS + (h >> 3) * KT_PLANE + (1 + j) * 128 + hp * 8 + (h & 7)] = f2bf(val);
                if (jq == 0 && e < 256) TKT[(size_t)g * KT_ELEMS + (e >> 7) * KT_PLANE + (e & 127)] = 0;
            }
#pragma unroll 1
            for (int jj = 0; jj < 4; ++jj) {
                const int j = 4 * jq + jj;
#pragma unroll
                for (int i = 0; i < 4; ++i) {
                    const int e = tid + 512 * i;
                    {
                        const int h = e & 15, col = e >> 4, cidx = col >> 6, p = col & 63;
                        const float2 A = shpow[(jj * 3 + 1) * 64 + p], bb = shB[p * 16 + h];
                        const float tr = A.x * bb.x - A.y * bb.y, ti = A.x * bb.y + A.y * bb.x;
                        TWST[(size_t)g * 32768 + j * 2048 + (col >> 5) * 512 + (h >> 3) * 256 + (col & 31) * 8 + (h & 7)] = f2bf(cidx ? ti : tr);
                    }
                    {
                        const int hp = e & 15, p = (e >> 4) & 63, cidx = e >> 10;
                        const float2 A = shpow[(jj * 3 + 2) * 64 + p], cc = shC[hp * 64 + p];
                        const float tr = cc.x * A.x - cc.y * A.y, ti = cc.x * A.y + cc.y * A.x;
                        const int ni = j >> 1, n = (j & 1) * 16 + hp, kk = cidx * 4 + (p >> 4), k = p & 15;
                        TWOUT[(size_t)g * 32768 + (kk * 8 + ni) * 512 + (k >> 3) * 256 + n * 8 + (k & 7)] = f2bf(cidx ? -ti : tr);
                    }
                }
            }
            __syncthreads();
        }
    }
    {
        float* scr = (float*)(lds + wave * 8448);
        constexpr int I_IN = 16 * 64, I_GLU = 8 * 16, I_OUT = 16 * 32, I_UP = 16 * 128, I_DN = 64 * 32;
        constexpr int NITEMS = I_IN + I_GLU + I_OUT + I_UP + I_DN;
        for (int it = gw; it < NITEMS; it += NGW) {
            int r = it;
            if (r < I_IN) { transpose_item(a.in[2], 1024, 2048, (bf16_t*)(ws + WS_WIN), scr, r, lane, nullptr, true); continue; } r -= I_IN;
            if (r < I_GLU) { transpose_item(a.in[11], 512, 512, (bf16_t*)(ws + WS_WGLU), scr, r, lane); continue; } r -= I_GLU;
            if (r < I_OUT) { transpose_item(a.in[15], 1024, 1024, (bf16_t*)(ws + WS_WOUT), scr, r, lane); continue; } r -= I_OUT;
            if (r < I_UP) { transpose_item(a.in[18], 1024, 4096, (bf16_t*)(ws + WS_WUP), scr, r, lane, a.in[17]); continue; } r -= I_UP;
            transpose_item(a.in[19], 4096, 1024, (bf16_t*)(ws + WS_WDN), scr, r, lane);
        }
    }
}
__device__ __forceinline__ float pair_sum(float v) {
    v += __shfl_xor(v, 1); v += __shfl_xor(v, 2); v += __shfl_xor(v, 4); v += __shfl_xor(v, 16); v += __shfl_xor(v, 32); return v;
}
__device__ __forceinline__ void phase_xnorm(const Args& a, const Ctx& c) {
    const int tid = threadIdx.x, lane = tid & 63, wave = tid >> 6;
    const int gw = c.vb * 8 + wave, NGW = c.GV * 8;
    { float* SS = (float*)(a.ws + WS_SS) + (size_t)c.grp * M_HALF; for (int i = c.vb * 512 + tid; i < M_HALF; i += c.GV * 512) SS[i] = 0.f; }
    const float* x = a.in[0] + (size_t)c.m0 * DM; const float* gp = a.in[1]; bf16_t* HN = (bf16_t*)(c.wsg + G_HN); float* RINV = (float*)(a.ws + WS_RINV) + (size_t)c.grp * M_HALF;
    const int sub = (lane >> 3) & 1, cl = 32 * (lane >> 4) + 4 * (lane & 7);
    f32x4 gv[8];
#pragma unroll
    for (int j = 0; j < 8; ++j) gv[j] = *(const f32x4*)(gp + cl + 128 * j);
    f32x4 v[8], nx[8];
#pragma unroll
    for (int j = 0; j < 8; ++j) v[j] = __builtin_nontemporal_load((const f32x4*)(x + (size_t)(2 * gw + sub) * DM + cl + 128 * j));
    for (int pr = gw; pr < M_HALF / 2; pr += NGW) {
        const int pn = pr + NGW, r = 2 * pr;
        if (pn < M_HALF / 2) {
#pragma unroll
            for (int j = 0; j < 8; ++j) nx[j] = __builtin_nontemporal_load((const f32x4*)(x + (size_t)(2 * pn + sub) * DM + cl + 128 * j));
        }
        float ss = 0.f;
#pragma unroll
        for (int j = 0; j < 8; ++j) ss += (v[j].x * v[j].x + v[j].y * v[j].y) + (v[j].z * v[j].z + v[j].w * v[j].w);
        const float q = pair_sum(ss) * (1.f / DM) + RMS_EPS, rr = rsqrtf(q);
        if ((lane & 0x37) == 0) RINV[r + sub] = q * rr;
        bf16_t* hb = HN + (size_t)(r >> 4) * 16384 + (r & 15) * 32 + (lane >> 4) * 512 + (lane & 15) * 4;
#pragma unroll
        for (int j = 0; j < 8; ++j) {
            u32x2 o; o.x = cvt_pk_bf16(v[j].x * rr * gv[j].x, v[j].y * rr * gv[j].y); o.y = cvt_pk_bf16(v[j].z * rr * gv[j].z, v[j].w * rr * gv[j].w);
            *(u32x2*)(hb + j * 2048) = o;
        }
#pragma unroll
        for (int j = 0; j < 8; ++j) v[j] = nx[j];
    }
}

__device__ __forceinline__ f32x16 mfma32(bf16x8 a, bf16x8 b, f32x16 c) { return __builtin_amdgcn_mfma_f32_32x32x16_bf16(a, b, c, 0, 0, 0); }
__device__ __forceinline__ void phase_ssm(const Args& a, const Ctx& c, unsigned char* ldsg) {
    const int tid = threadIdx.x, lane = tid & 63, wave = __builtin_amdgcn_readfirstlane(tid >> 6);
    unsigned char* ws = a.ws;
    const bf16_t* lw = (const bf16_t*)ldsg;
    float2* shE = (float2*)(ldsg + 139776);
    const bf16_t* U3 = (const bf16_t*)(c.wsg + G_U3);
    bf16_t* YG = (bf16_t*)(c.wsg + G_YG);
    const float4* TSC = (const float4*)(ws + WS_TSC);
    const int boff = (lane >> 5) * 256 + (lane & 31) * 8;
    const int koff = (lane >> 5) * KT_PLANE + (lane & 31) * 8;
    for (int item = c.vb; item < 128; item += c.GV) {
        const int b = item >> 5, g = item & 31;
        {
            const u32x4* s0 = (const u32x4*)(ws + WS_TWST + (size_t)g * 65536); u32x4* d0 = (u32x4*)ldsg;
            const u32x4* s1 = (const u32x4*)(ws + WS_TWOUT + (size_t)g * 65536); u32x4* d1 = (u32x4*)(ldsg + 65536);
            const u32x4* s2 = (const u32x4*)(ws + WS_TKT + (size_t)g * (KT_ELEMS * 2)); u32x4* d2 = (u32x4*)(ldsg + 131072);
#pragma unroll
            for (int i = 0; i < 8; ++i) { d0[tid + 512 * i] = s0[tid + 512 * i]; d1[tid + 512 * i] = s1[tid + 512 * i]; }
            for (int i = tid; i < (KT_ELEMS * 2) / 16; i += 512) d2[i] = s2[i];
        }
        __syncthreads();
        const bf16_t* Ubg = U3 + (size_t)item * 131072;
        const bf16_t* Ul = Ubg + (lane & 31) * 256 + (lane >> 5) * 8;
        float* Sw = (float*)(c.wsg + G_SWS) + (size_t)item * 65536;
        bf16_t* Cw = (bf16_t*)(c.wsg + G_CWS) + (size_t)item * 65536;
        for (int q = 0; q < 2; ++q) {
            const int mb = wave * 2 + q;
            bf16x8 ua[16];
#pragma unroll
            for (int s = 0; s < 16; ++s) ua[s] = *(const bf16x8*)(Ul + mb * 8192 + s * 16);
#pragma unroll 1
            for (int nb = 0; nb < 4; ++nb) {
                f32x16 acc;
#pragma unroll
                for (int r = 0; r < 16; ++r) acc[r] = 0.f;
#pragma unroll
                for (int s = 0; s < 16; ++s) { const bf16x8 B = *(const bf16x8*)(lw + (s * 4 + nb) * 512 + boff); acc = mfma32(ua[s], B, acc); }
#pragma unroll
                for (int r = 0; r < 16; ++r) { const int row = (r & 3) + 8 * (r >> 2) + 4 * (lane >> 5); Sw[(size_t)(mb * 32 + row) * 128 + nb * 32 + (lane & 31)] = acc[r]; }
            }
        }
        __builtin_amdgcn_fence(__ATOMIC_RELEASE, "workgroup"); asm volatile("s_waitcnt vmcnt(0)" ::: "memory"); __builtin_amdgcn_fence(__ATOMIC_ACQUIRE, "workgroup");
        {
            const float4 sc = TSC[g * 64 + lane];
            const float* Sp = Sw + (size_t)(wave * 64) * 128 + lane;
            float sr[32], si[32];
            float xr = 0.f, xi = 0.f;
#pragma unroll 1
            for (int hb = 0; hb < 2; ++hb) {
#pragma unroll
                for (int n = 0; n < 32; ++n) { sr[n] = Sp[(hb * 32 + n) * 128]; si[n] = Sp[(hb * 32 + n) * 128 + 64]; }
#pragma unroll
                for (int n = 0; n < 32; ++n) { const float nr = sc.x * xr - sc.y * xi + sr[n], ni = sc.x * xi + sc.y * xr + si[n]; xr = nr; xi = ni; }
            }
            shE[wave * 64 + lane] = make_float2(xr, xi);
            __syncthreads();
            xr = 0.f; xi = 0.f;
            for (int v = 0; v < wave; ++v) { const float2 e = shE[v * 64 + lane]; const float nr = sc.z * xr - sc.w * xi + e.x, ni = sc.z * xi + sc.w * xr + e.y; xr = nr; xi = ni; }
            bf16_t* Cp = Cw + (size_t)(wave * 64) * 128 + lane;
#pragma unroll 1
            for (int hb = 0; hb < 2; ++hb) {
#pragma unroll
                for (int n = 0; n < 32; ++n) { sr[n] = Sp[(hb * 32 + n) * 128]; si[n] = Sp[(hb * 32 + n) * 128 + 64]; }
#pragma unroll
                for (int n = 0; n < 32; ++n) {
                    Cp[(hb * 32 + n) * 128] = f2bf(xr); Cp[(hb * 32 + n) * 128 + 64] = f2bf(xi);
                    const float nr = sc.x * xr - sc.y * xi + sr[n], ni = sc.x * xi + sc.y * xr + si[n]; xr = nr; xi = ni;
                }
            }
        }
        __builtin_amdgcn_fence(__ATOMIC_RELEASE, "workgroup"); asm volatile("s_waitcnt vmcnt(0)" ::: "memory"); __builtin_amdgcn_fence(__ATOMIC_ACQUIRE, "workgroup");
        for (int q = 0; q < 2; ++q) {
            const int mb = wave * 2 + q;
            bf16x8 ua[16], ca[8];
#pragma unroll
            for (int s = 0; s < 16; ++s) ua[s] = *(const bf16x8*)(Ul + mb * 8192 + s * 16);
#pragma unroll
            for (int kk = 0; kk < 8; ++kk) ca[kk] = *(const bf16x8*)(Cw + (size_t)(mb * 32 + (lane & 31)) * 128 + kk * 16 + (lane >> 5) * 8);
#pragma unroll 1
            for (int ni = 0; ni < 8; ++ni) {
                f32x16 acc;
#pragma unroll
                for (int r = 0; r < 16; ++r) acc[r] = 0.f;
#pragma unroll
                for (int s = 0; s < 16; ++s) if (s <= 2 * ni + 1) { const bf16x8 B = *(const bf16x8*)(lw + 65536 + (2 * ni - s + 1) * 128 + koff); acc = mfma32(ua[s], B, acc); }
#pragma unroll
                for (int kk = 0; kk < 8; ++kk) { const bf16x8 B = *(const bf16x8*)(lw + 32768 + (kk * 8 + ni) * 512 + boff); acc = mfma32(ca[kk], B, acc); }
                const int tau = 2 * ni + ((lane & 31) >> 4), hp = lane & 15;
#pragma unroll
                for (int r = 0; r < 16; ++r) {
                    const int row = (r & 3) + 8 * (r >> 2) + 4 * (lane >> 5);
                    const int tl = (mb * 32 + row) * 16 + tau;
                    YG[((size_t)(b * SEQ + tl)) * 512 + g * 16 + hp] = f2bf(gelu_tanh(acc[r]));
                }
            }
        }
        __syncthreads();
    }
}

__device__ __forceinline__ void unpack8(const u32x4 w, float (&f)[8]) { f[0] = bf_lo(w.x); f[1] = bf_hi(w.x); f[2] = bf_lo(w.y); f[3] = bf_hi(w.y); f[4] = bf_lo(w.z); f[5] = bf_hi(w.z); f[6] = bf_lo(w.w); f[7] = bf_hi(w.w); }
__device__ __forceinline__ u32x4 pack8(const float (&f)[8]) { u32x4 w; w.x = cvt_pk_bf16(f[0], f[1]); w.y = cvt_pk_bf16(f[2], f[3]); w.z = cvt_pk_bf16(f[4], f[5]); w.w = cvt_pk_bf16(f[6], f[7]); return w; }
__device__ __forceinline__ void phase_mix(const Args& a, const Ctx& c) {
    const int tid = threadIdx.x, lane = tid & 63, wave = tid >> 6;
    const int gw = c.vb * 8 + wave, NGW = c.GV * 8;
    const bf16_t* P = (const bf16_t*)(c.wsg + G_PROJ); bf16_t* YCAT = (bf16_t*)(c.wsg + G_YCAT); const float* SS = (const float*)(a.ws + WS_SS) + (size_t)c.grp * M_HALF;
    const float* cw = a.in[12]; const float* gc = a.in[14];
    const int j0 = 8 * lane;
    float w0[8], w1[8], w2[8], gcv[8];
#pragma unroll
    for (int j = 0; j < 8; ++j) { w0[j] = cw[j0 + j]; w1[j] = cw[512 + j0 + j]; w2[j] = cw[1024 + j0 + j]; gcv[j] = gc[j0 + j]; }
    constexpr int STRIP = 32;
    for (int st = gw; st < M_HALF / STRIP; st += NGW) {
        const int row0 = st * STRIP;
        float zp2[8], zp1[8];
        if ((row0 & (SEQ - 1)) == 0) {
#pragma unroll
            for (int j = 0; j < 8; ++j) { zp2[j] = 0.f; zp1[j] = 0.f; }
        } else {
            unpack8(*(const u32x4*)(P + (size_t)(row0 - 2) * 1024 + j0), zp2);
            unpack8(*(const u32x4*)(P + (size_t)(row0 - 1) * 1024 + j0), zp1);
        }
        constexpr int PR = 4;
        u32x4 lz[PR], lb[PR], nz[PR], nb[PR]; float ly[PR], ny[PR];
#pragma unroll
        for (int k = 0; k < PR; ++k) { const size_t r = (size_t)(row0 + k); lz[k] = *(const u32x4*)(P + r * 1024 + j0); lb[k] = *(const u32x4*)(P + r * 1024 + 512 + j0); ly[k] = SS[r]; }
        for (int i = 0; i < STRIP; i += PR) {
            if (i + PR < STRIP) {
#pragma unroll
                for (int k = 0; k < PR; ++k) { const size_t r = (size_t)(row0 + i + PR + k); nz[k] = *(const u32x4*)(P + r * 1024 + j0); nb[k] = *(const u32x4*)(P + r * 1024 + 512 + j0); ny[k] = SS[r]; }
            }
#pragma unroll
            for (int k = 0; k < PR; ++k) {
                const int row = row0 + i + k;
                float bg[8], z[8], yc[8];
                unpack8(lz[k], z); unpack8(lb[k], bg);
                float ssc = 0.f;
#pragma unroll
                for (int j = 0; j < 8; ++j) { yc[j] = bg[j] * (w0[j] * zp2[j] + w1[j] * zp1[j] + w2[j] * z[j]); ssc += yc[j] * yc[j]; }
                ssc = wave_sum(ssc);
                const float rc = rsqrtf(ssc * (1.f / 512.f) + RMS_EPS) * sqrtf(ly[k] * (1.f / 512.f) + RMS_EPS);
#pragma unroll
                for (int j = 0; j < 8; ++j) { yc[j] = yc[j] * rc * gcv[j]; zp2[j] = zp1[j]; zp1[j] = z[j]; }
                *(u32x4*)(YCAT + (size_t)row * 1024 + 512 + j0) = pack8(yc);
            }
#pragma unroll
            for (int k = 0; k < PR; ++k) { lz[k] = nz[k]; lb[k] = nb[k]; ly[k] = ny[k]; }
        }
    }
}

__device__ __forceinline__ void phase_resid6(const Args& a, const Ctx& c) {
    const int tid = threadIdx.x, lane = tid & 63, wave = tid >> 6;
    const int gw = c.vb * 8 + wave, NGW = c.GV * 8;
    const bf16_t* HN = (const bf16_t*)(c.wsg + G_HN); const float* RINV = (const float*)(a.ws + WS_RINV) + (size_t)c.grp * M_HALF;
    const bf16_t* O = (const bf16_t*)(c.wsg + G_O); bf16_t* X1B = (bf16_t*)(c.wsg + G_X1B);
    const float* SS = (const float*)(a.ws + WS_SS) + (size_t)c.grp * M_HALF;
    const int sub = (lane >> 3) & 1, cl = 32 * (lane >> 4) + 4 * (lane & 7), lo = (lane >> 4) * 512 + (lane & 15) * 4;
    f32x4 g1[8], gi[8];
#pragma unroll
    for (int j = 0; j < 8; ++j) { g1[j] = *(const f32x4*)(a.in[16] + cl + 128 * j); const f32x4 g0 = *(const f32x4*)(a.in[1] + cl + 128 * j); gi[j] = (f32x4){1.f / g0.x, 1.f / g0.y, 1.f / g0.z, 1.f / g0.w}; }
    u32x2 xv[8], nxv[8], ov[8], nov[8]; float ssv, nssv = 0.f, riv, nriv = 0.f;
    { const int r = 2 * gw; const size_t bo = (size_t)(r >> 4) * 16384 + (r & 15) * 32 + lo; ssv = SS[r + sub]; riv = RINV[r + sub];
#pragma unroll
      for (int j = 0; j < 8; ++j) { xv[j] = *(const u32x2*)(HN + bo + j * 2048); ov[j] = *(const u32x2*)(O + bo + j * 2048); } }
    for (int pr = gw; pr < M_HALF / 2; pr += NGW) {
        const int pn = pr + NGW, r = 2 * pr;
        if (pn < M_HALF / 2) { const int rn = 2 * pn; const size_t bo = (size_t)(rn >> 4) * 16384 + (rn & 15) * 32 + lo; nssv = SS[rn + sub]; nriv = RINV[rn + sub];
#pragma unroll
            for (int j = 0; j < 8; ++j) { nxv[j] = *(const u32x2*)(HN + bo + j * 2048); nov[j] = *(const u32x2*)(O + bo + j * 2048); } }
        f32x4 of[8]; float so = 0.f;
#pragma unroll
        for (int j = 0; j < 8; ++j) { of[j] = (f32x4){bf_lo(ov[j].x), bf_hi(ov[j].x), bf_lo(ov[j].y), bf_hi(ov[j].y)}; so += (of[j].x * of[j].x + of[j].y * of[j].y) + (of[j].z * of[j].z + of[j].w * of[j].w); }
        const float ro = rsqrtf(pair_sum(so) * (1.f / DM) + RMS_EPS * (ssv * (1.f / 512.f) + RMS_EPS));
        bf16_t* xb = X1B + (size_t)(r >> 4) * 16384 + (r & 15) * 32 + lo;
#pragma unroll
        for (int j = 0; j < 8; ++j) {
            const f32x4 xr = (f32x4){bf_lo(xv[j].x), bf_hi(xv[j].x), bf_lo(xv[j].y), bf_hi(xv[j].y)} * gi[j] * riv;
            const f32x4 x1 = xr + of[j] * ro * g1[j];
            u32x2 q; q.x = cvt_pk_bf16(x1.x, x1.y); q.y = cvt_pk_bf16(x1.z, x1.w); *(u32x2*)(xb + j * 2048) = q;
        }
#pragma unroll
        for (int j = 0; j < 8; ++j) { xv[j] = nxv[j]; ov[j] = nov[j]; }
        ssv = nssv; riv = nriv;
    }
}
__device__ __forceinline__ void phase_final(const Args& a, const Ctx& c, int tg, int p_lo, int p_hi) {
    const int tid = threadIdx.x, lane = tid & 63, wave = tid >> 6;
    const int gw = p_lo + c.vb * 8 + wave, NGW = c.GV * 8;
    if (gw >= p_hi) return;
    float* outp = a.out + (size_t)tg * M_HALF * DM;
    const unsigned char* wst = a.ws + WS_GROUP0 + (size_t)tg * GROUP_BYTES;
    const bf16_t* MO = (const bf16_t*)(wst + G_HN); const bf16_t* X1B = (const bf16_t*)(wst + G_X1B);
    const int sub = (lane >> 3) & 1, cl = 32 * (lane >> 4) + 4 * (lane & 7), lo = (lane >> 4) * 512 + (lane & 15) * 4;
    f32x4 g2[8];
#pragma unroll
    for (int j = 0; j < 8; ++j) g2[j] = *(const f32x4*)(a.in[20] + cl + 128 * j);
    u32x2 xv[8], nxv[8], mv[8], nmv[8];
    { const int r = 2 * gw; const size_t bo = (size_t)(r >> 4) * 16384 + (r & 15) * 32 + lo;
#pragma unroll
      for (int j = 0; j < 8; ++j) { xv[j] = *(const u32x2*)(X1B + bo + j * 2048); mv[j] = *(const u32x2*)(MO + bo + j * 2048); } }
    for (int pr = gw; pr < p_hi; pr += NGW) {
        const int pn = pr + NGW, r = 2 * pr;
        if (pn < p_hi) { const int rn = 2 * pn; const size_t bo = (size_t)(rn >> 4) * 16384 + (rn & 15) * 32 + lo;
#pragma unroll
            for (int j = 0; j < 8; ++j) { nxv[j] = *(const u32x2*)(X1B + bo + j * 2048); nmv[j] = *(const u32x2*)(MO + bo + j * 2048); } }
        f32x4 mf[8], x1[8]; float sm = 0.f, s1 = 0.f;
#pragma unroll
        for (int j = 0; j < 8; ++j) { mf[j] = (f32x4){bf_lo(mv[j].x), bf_hi(mv[j].x), bf_lo(mv[j].y), bf_hi(mv[j].y)};
            x1[j] = (f32x4){bf_lo(xv[j].x), bf_hi(xv[j].x), bf_lo(xv[j].y), bf_hi(xv[j].y)};
            sm += (mf[j].x * mf[j].x + mf[j].y * mf[j].y) + (mf[j].z * mf[j].z + mf[j].w * mf[j].w);
            s1 += (x1[j].x * x1[j].x + x1[j].y * x1[j].y) + (x1[j].z * x1[j].z + x1[j].w * x1[j].w); }
        sm = pair_sum(sm); s1 = pair_sum(s1);
        const float q1 = s1 * (1.f / DM) + RMS_EPS;
        const float rm = rsqrtf(sm * (1.f / DM) + RMS_EPS * q1 * q1);
        float* ob = outp + (size_t)(r + sub) * DM + cl;
#pragma unroll
        for (int j = 0; j < 8; ++j) __builtin_nontemporal_store(x1[j] + mf[j] * rm * g2[j], (f32x4*)(ob + 128 * j));
#pragma unroll
        for (int j = 0; j < 8; ++j) { xv[j] = nxv[j]; mv[j] = nmv[j]; }
    }
}

template <class Epi, bool ABLK = false> __device__ __forceinline__ void run_gemm(unsigned char* lds, const Ctx& c, const bf16_t* A, const bf16_t* Bt, int N, int K, const Epi& E, int rev = 0) {
    pg8::StaticOrder S; S.init(M_HALF, N, c.GV, c.vb, 4, rev);
    pg8::gemm_phase<Epi, pg8::StaticOrder, true, true, ABLK>((PG8_LAS unsigned char*)lds, pg8::Gemm{A, Bt, M_HALF, N, K}, S, E);
}
#ifdef PROBE_DUMMY
struct ProbeOrder : pg8::StaticOrder {
    int mode;
    __device__ bool next(int i, pg8::Unit& u) const { if (mode) { if (i >= 16) return false; u.pm = 0; u.pn = 0; return true; } return pg8::StaticOrder::next(i, u); }
};
#endif
__global__ void __launch_bounds__(512, 2) hymba_fwd(Args a) {
    extern __shared__ __attribute__((aligned(16))) unsigned char lds[];
    Ctx c;
    c.GV = (int)gridDim.x >> 1; c.grp = ((int)blockIdx.x & 7) >> 2; c.vb = (((int)blockIdx.x >> 3) << 2) | ((int)blockIdx.x & 3);
    c.m0 = c.grp * M_HALF; c.wsg = a.ws + WS_GROUP0 + (size_t)c.grp * GROUP_BYTES;
    unsigned char* ws = a.ws; unsigned char* wsg = c.wsg;
    volatile LAS unsigned* st = (volatile LAS unsigned*)((LAS unsigned char*)lds + LDS_ST_OFF);
    if (threadIdx.x < 4) st[threadIdx.x] = 0u;
    __syncthreads();
    const XcdBarrier gb = xcd_barrier_post((unsigned*)(ws + WS_BAR + (size_t)c.grp * BAR_STRIDE), st, (unsigned)c.GV);
    unsigned* wready = (unsigned*)(ws + WS_BAR + 2 * BAR_STRIDE);
    if (a.ph_lo < 0) cg::this_grid().sync();
    if (c.grp == 1) {
        phase_prep_w(a, c, lds);
#if defined(PROBE_X2) && (PROBE_X2 & 1)
        __syncthreads(); phase_prep_w(a, c, lds);
#endif
        asm volatile("s_waitcnt vmcnt(0)" ::: "memory");
        __syncthreads();
        if (threadIdx.x == 0) {
            __builtin_amdgcn_fence(__ATOMIC_RELEASE, "agent");
            asm volatile("s_waitcnt vmcnt(0)" ::: "memory");
            (void)__hip_atomic_fetch_add(wready, 1u, __ATOMIC_RELAXED, __HIP_MEMORY_SCOPE_AGENT);
        }
        phase_xnorm(a, c);
    } else {
        phase_xnorm(a, c);
        if (threadIdx.x == 0) {
            unsigned sp = 0;
            while (__hip_atomic_load(wready, __ATOMIC_RELAXED, __HIP_MEMORY_SCOPE_AGENT) < (unsigned)c.GV) { __builtin_amdgcn_s_sleep(2); if (++sp > (1u << 22)) break; }
            __builtin_amdgcn_fence(__ATOMIC_ACQUIRE, "agent");
            asm volatile("s_waitcnt vmcnt(0)" ::: "memory");
        }
        __syncthreads();
    }
    xcd_barrier(gb);
    run_gemm<EpiProj, true>(lds, c, (const bf16_t*)(wsg + G_HN), (const bf16_t*)(ws + WS_WIN), 2048, 1024, EpiProj{(bf16_t*)(wsg + G_U3), (bf16_t*)(wsg + G_PROJ)});
    xcd_barrier(gb);
    phase_ssm(a, c, lds);
    xcd_barrier(gb);
    run_gemm(lds, c, (const bf16_t*)(wsg + G_YG), (const bf16_t*)(ws + WS_WGLU), 512, 512, EpiGlu{(const bf16_t*)(wsg + G_YG), (bf16_t*)(wsg + G_YCAT), a.in[13], (float*)(ws + WS_SS) + (size_t)c.grp * M_HALF});
    xcd_barrier(gb);
    phase_mix(a, c);
#if defined(PROBE_X2) && (PROBE_X2 & 2)
    if (c.grp == 1) phase_mix(a, c);
#endif
    xcd_barrier(gb);
    run_gemm(lds, c, (const bf16_t*)(wsg + G_YCAT), (const bf16_t*)(ws + WS_WOUT), 1024, 1024, EpiStoreBlk<0>{(bf16_t*)(wsg + G_O), 1024});
    xcd_barrier(gb);
    phase_resid6(a, c);
#if defined(PROBE_X2) && (PROBE_X2 & 2)
    if (c.grp == 1) phase_resid6(a, c);
#endif
    xcd_barrier(gb);
#ifdef PROBE_DUMMY
#pragma unroll 1
    for (int rp = 0; rp < 2; ++rp) {
        ProbeOrder S; S.init(M_HALF, 4096, c.GV, c.vb, 4); S.mode = rp;
        EpiStore<1> E{rp ? (bf16_t*)(ws + WS_END) : (bf16_t*)(wsg + G_H), 4096};
        pg8::gemm_phase<EpiStore<1>, ProbeOrder, true, true>((PG8_LAS unsigned char*)lds, pg8::Gemm{(const bf16_t*)(wsg + G_X1B), (const bf16_t*)(ws + WS_WUP), M_HALF, 4096, 1024}, S, E);
        xcd_barrier(gb);
    }
#elif defined(PROBE_UP2)
#pragma unroll 1
    for (int rp = 0; rp < (c.grp == 1 ? 2 : 1); ++rp) {
        run_gemm(lds, c, (const bf16_t*)(wsg + G_X1B), (const bf16_t*)(ws + WS_WUP), 4096, 1024, EpiStore<1>{(bf16_t*)(wsg + G_H), 4096});
        xcd_barrier(gb);
    }
#else
    run_gemm<EpiStoreBlk<1>, true>(lds, c, (const bf16_t*)(wsg + G_X1B), (const bf16_t*)(ws + WS_WUP), 4096, 1024, EpiStoreBlk<1>{(bf16_t*)(wsg + G_H), 4096});
    xcd_barrier(gb);
#endif
    run_gemm<EpiStoreBlk<0>, true>(lds, c, (const bf16_t*)(wsg + G_H), (const bf16_t*)(ws + WS_WDN), 1024, 4096, EpiStoreBlk<0>{(bf16_t*)(wsg + G_HN), 1024}, 1);
    xcd_barrier(gb);
    constexpr int NPAIR = M_HALF / 2, HELP = 3 * NPAIR / 16;
    unsigned* ddone = wready + 128;
    if (c.grp == 1 && threadIdx.x == 0) (void)__hip_atomic_fetch_add(ddone, 1u, __ATOMIC_RELAXED, __HIP_MEMORY_SCOPE_AGENT);
#pragma unroll 1
    for (int run = 0; run < (c.grp == 0 ? 2 : 1); ++run) {
        if (run == 1) {
            if (threadIdx.x == 0) {
                unsigned sp = 0;
                while (__hip_atomic_load(ddone, __ATOMIC_RELAXED, __HIP_MEMORY_SCOPE_AGENT) == 0u) { __builtin_amdgcn_s_sleep(2); if (++sp > (1u << 22)) break; }
                __builtin_amdgcn_fence(__ATOMIC_ACQUIRE, "agent");
                asm volatile("s_waitcnt vmcnt(0)" ::: "memory");
            }
            __syncthreads();
        }
        const int tg = run == 1 ? 1 : c.grp;
        const int p_lo = run == 1 ? NPAIR - HELP : 0, p_hi = (c.grp == 1) ? NPAIR - HELP : NPAIR;
        phase_final(a, c, tg, p_lo, p_hi);
    }
}

extern "C" void kernel_launch(void* const* d_in, const int* in_sizes, int n_in, void* d_out, int out_size, void* d_ws, size_t ws_size, hipStream_t stream) {
    static int grid = 0;
    if (grid == 0) {
        if (n_in != 21 || in_sizes[0] != M_TOK * DM || out_size != M_TOK * DM || ws_size < WS_END) {
            fprintf(stderr, "kernel_launch: unexpected shapes (n_in %d, in0 %d, out %d, ws %zu < %zu)\n", n_in, n_in > 0 ? in_sizes[0] : -1, out_size, ws_size, (size_t)WS_END); grid = -1; return; }
        int dev = 0, cus = 0, per_cu = 0;
        (void)hipGetDevice(&dev); (void)hipDeviceGetAttribute(&cus, hipDeviceAttributeMultiprocessorCount, dev);
        if (hipFuncSetAttribute((const void*)hymba_fwd, hipFuncAttributeMaxDynamicSharedMemorySize, LDS_BYTES) != hipSuccess) fprintf(stderr, "kernel_launch: hipFuncSetAttribute failed\n");
        if (hipOccupancyMaxActiveBlocksPerMultiprocessor(&per_cu, (const void*)hymba_fwd, 512, LDS_BYTES) != hipSuccess || per_cu < 1) { fprintf(stderr, "kernel_launch: occupancy query says %d\n", per_cu); per_cu = 1; }
        (void)hipGetLastError();
        grid = cus * per_cu;
        if (grid > 256) grid = 256;
        grid &= ~15;
        if (grid < 16) { fprintf(stderr, "kernel_launch: grid %d too small\n", grid); grid = -1; return; }
    }
    if (grid < 0) return;
    Args a{};
    for (int i = 0; i < 21; ++i) a.in[i] = (const float*)d_in[i];
    a.out = (float*)d_out; a.ws = (unsigned char*)d_ws;
    a.ph_lo = 0; a.ph_hi = N_PHASES;
    if (hipMemsetAsync((unsigned char*)d_ws + WS_BAR, 0, BAR_BYTES, stream) != hipSuccess) { fprintf(stderr, "kernel_launch: memset of the barrier words failed\n"); return; }
    void* args[] = {&a};
    hipError_t e = hipLaunchCooperativeKernel((const void*)hymba_fwd, dim3(grid), dim3(512), args, LDS_BYTES, stream);
    if (e != hipSuccess) fprintf(stderr, "kernel_launch: cooperative launch failed: %s (grid %d)\n", hipGetErrorString(e), grid);
}
```

```cpp
#define MK_MULTI 0
#include <hip/hip_runtime.h>
namespace pg8 {
#define PG8_LAS __attribute__((address_space(3)))
typedef unsigned short bf16_t;
typedef short bf16x8 __attribute__((ext_vector_type(8)));
typedef float f32x4 __attribute__((ext_vector_type(4)));
typedef unsigned u32x4 __attribute__((ext_vector_type(4)));
constexpr int BM = 256, BK = 64, HALF = 128, HTB = HALF * BK * 2  , STAGE_BYTES = 8 * HTB, NXCD = 8, WGM = 8;

__host__ __device__ __forceinline__ int lds_byte(int r, int c) { const int st = (r >> 4) * 2 + (c >> 5), rr = r & 15, cc = c & 31, ob = rr * 64 + cc * 2; return st * 1024 + (ob ^ (((ob >> 9) & 1) << 5)); }
__host__ __device__ __forceinline__ void stage_rc(int b, int& R, int& C) { const int st = b / 1024, sb = b % 1024, swz = sb ^ (((sb >> 9) & 1) << 5); R = (st >> 1) * 16 + swz / 64; C = (st & 1) * 32 + (swz % 64) / 2; }
__host__ __device__ __forceinline__ int perm32(int rho) { const int n = rho >> 4, i = rho & 15; return 8 * (i >> 2) + 4 * n + (i & 3); }

struct Unit { int pm, pn; };
struct Gemm { const bf16_t* A; const bf16_t* Bt; int M, N, K; };

struct StaticOrder {
    int nM, nN, nwg, G, c, nx, rev;
    __host__ __device__ void init(int M, int N, int G_, int c_, int nx_ = NXCD, int rev_ = 0) { nM = M / BM; nN = N / BM; nwg = nM * nN; G = G_; c = c_; nx = nx_; rev = (rev_ && nwg % G_ == 0) ? 1 : 0; }
    __host__ __device__ bool next(int i, Unit& u) const {
        const long L = (long)(rev ? (nwg / G - 1 - i) : i) * G + c; if (L >= nwg || L < 0) return false;
        int wgid = (int)L; { const int q = nwg / nx, r = nwg % nx, xcd = wgid % nx, off = wgid / nx; wgid = (xcd < r ? xcd * (q + 1) : r * (q + 1) + (xcd - r) * q) + off; }
        const int nig = WGM * nN, gid = wgid / nig, fm = gid * WGM, gsz = (nM - fm) < WGM ? (nM - fm) : WGM;
        u.pm = fm + ((wgid % nig) % gsz); u.pn = (wgid % nig) / gsz; return true;
    }
    __device__ __forceinline__ void a_ready(const Unit&) const {}
    __device__ __forceinline__ void done(const Unit&) const {}
};
__device__ __forceinline__ unsigned cvt_pk_bf16(float lo, float hi) { unsigned r; asm("v_cvt_pk_bf16_f32 %0, %1, %2" : "=v"(r) : "v"(lo), "v"(hi)); return r; }
template <class Epi, class Sched, bool ALIGN_EPI = false, bool SP2 = false, bool ABLK = false>
__device__ __forceinline__ void gemm_phase(PG8_LAS unsigned char* lds, const Gemm g, const Sched& S, const Epi& E) {
    const int tid = threadIdx.x, wid = __builtin_amdgcn_readfirstlane(tid >> 6), lane = tid & 63, wr = wid >> 2, wc = wid & 3, fr = lane & 15, fq = lane >> 4;
    const int K = g.K, nt = K / BK;
    unsigned voffA[2], voffB[2];
#pragma unroll
    for (int i = 0; i < 2; ++i) { int R, C; stage_rc(tid * 16 + i * 8192, R, C); const int Rb = Epi::PERM ? ((R & ~31) + perm32(R & 31)) : R;
        voffA[i] = ABLK ? (unsigned)(((((R >> 4) * (K >> 5) + (C >> 5)) * 16 + (R & 15)) * 32 + (C & 31))) * 2u : (unsigned)(R * K + C) * 2u; voffB[i] = (unsigned)(Rb * K + C) * 2u; }
    const size_t kstep = (size_t)(BK * 2);
    const size_t kstepA = ABLK ? (size_t)2048 : kstep;
    const size_t hstep = (size_t)HALF * K * 2;
    const size_t tstep = 2 * hstep;
    const unsigned ldsw = (unsigned)wid * 1024u;
    const int aoff = lds_byte(wr * 64 + fr, fq * 8), boff = lds_byte(wc * 32 + fr, fq * 8);
#define PG8_SA(b, h) (((b) * 2 + (h)) * HTB)
#define PG8_SB(b, h) ((4 + (b) * 2 + (h)) * HTB)
#define PG8_STAGE(bufoff, gbase, voff) do { _Pragma("unroll") for (int _i = 0; _i < 2; ++_i) \
        __builtin_amdgcn_global_load_lds((const unsigned*)((const char*)(gbase) + (voff)[_i]), (PG8_LAS unsigned*)(lds + (bufoff) + ldsw + _i * 8192), 16, 0, 0); } while (0)
#define PG8_LDA(dst, b, h) do { _Pragma("unroll") for (int m = 0; m < 4; ++m) _Pragma("unroll") for (int k = 0; k < 2; ++k) dst[m][k] = *(const PG8_LAS bf16x8*)(lds + PG8_SA(b, h) + aoff + m * 2048 + k * 1024); } while (0)
#define PG8_LDB(dst, b, h) do { _Pragma("unroll") for (int n = 0; n < 2; ++n) _Pragma("unroll") for (int k = 0; k < 2; ++k) dst[n][k] = *(const PG8_LAS bf16x8*)(lds + PG8_SB(b, h) + boff + n * 2048 + k * 1024); } while (0)
#define PG8_MMA(ai, bj, At, Bt) do { __builtin_amdgcn_s_setprio(1); _Pragma("unroll") for (int m = 0; m < 4; ++m) _Pragma("unroll") for (int n = 0; n < 2; ++n) _Pragma("unroll") for (int k = 0; k < 2; ++k) \
        acc[ai][bj][m][n] = __builtin_amdgcn_mfma_f32_16x16x32_bf16(Bt[n][k], At[m][k], acc[ai][bj][m][n], 0, 0, 0); __builtin_amdgcn_s_setprio(0); } while (0)
#define PG8_MMAQ(ai, bj, At, Bt) do { _Pragma("unroll") for (int m = 0; m < 4; ++m) _Pragma("unroll") for (int n = 0; n < 2; ++n) _Pragma("unroll") for (int k = 0; k < 2; ++k) \
        acc[ai][bj][m][n] = __builtin_amdgcn_mfma_f32_16x16x32_bf16(Bt[n][k], At[m][k], acc[ai][bj][m][n], 0, 0, 0); } while (0)
#define PG8_WAIT_V(n) asm volatile("s_waitcnt vmcnt(" #n ")" ::: "memory")
#define PG8_WAIT_L(n) asm volatile("s_waitcnt lgkmcnt(" #n ")" ::: "memory")
#define PG8_BAR __builtin_amdgcn_s_barrier()
#define PG8_SCHED __builtin_amdgcn_sched_barrier(0)
    Unit cur, nxt; int ui = 0;
    if (!S.next(0, cur)) return;
    f32x4 acc[2][2][4][2];
#pragma unroll
    for (int a = 0; a < 2; ++a)
#pragma unroll
        for (int b = 0; b < 2; ++b)
#pragma unroll
            for (int m = 0; m < 4; ++m)
#pragma unroll
                for (int n = 0; n < 2; ++n) acc[a][b][m][n] = (f32x4){0.f, 0.f, 0.f, 0.f};
    bf16x8 At[4][2], B0[2][2], B1[2][2];
    const char* cA = (const char*)g.A + (size_t)cur.pm * tstep; const char* cB = (const char*)g.Bt + (size_t)cur.pn * tstep;
    S.a_ready(cur);
    if constexpr (SP2) {
        PG8_STAGE(PG8_SB(0, 0), cB, voffB); PG8_STAGE(PG8_SB(0, 1), cB + hstep, voffB); PG8_STAGE(PG8_SA(0, 0), cA, voffA); PG8_STAGE(PG8_SA(0, 1), cA + hstep, voffA);
        if (wr == 1) PG8_BAR;
        PG8_WAIT_V(2); PG8_BAR;
        PG8_STAGE(PG8_SB(1, 0), cB + kstep, voffB); PG8_STAGE(PG8_SA(1, 0), cA + kstepA, voffA); PG8_STAGE(PG8_SB(1, 1), cB + hstep + kstep, voffB);
        PG8_WAIT_V(6); PG8_BAR;
    } else {
        PG8_STAGE(PG8_SB(0, 0), cB, voffB); PG8_STAGE(PG8_SA(0, 0), cA, voffA); PG8_STAGE(PG8_SB(0, 1), cB + hstep, voffB); PG8_STAGE(PG8_SA(0, 1), cA + hstep, voffA);
        if (wr == 1) PG8_BAR;
        PG8_WAIT_V(4); PG8_BAR;
        PG8_STAGE(PG8_SB(1, 0), cB + kstep, voffB); PG8_STAGE(PG8_SA(1, 0), cA + kstepA, voffA); PG8_STAGE(PG8_SB(1, 1), cB + hstep + kstep, voffB);
        PG8_WAIT_V(6); PG8_BAR;
    }
    for (;;) {
        const bool has_next = S.next(ui + 1, nxt);
        const char* nA = has_next ? (const char*)g.A + (size_t)nxt.pm * tstep : cA; const char* nB = has_next ? (const char*)g.Bt + (size_t)nxt.pn * tstep : cB;
        for (int t = 0; t < nt; t += 2) {
            const bool last = (t == nt - 2);
            const char* a1 = cA + (size_t)(t + 1) * kstepA;
            const char* a2 = last ? nA : cA + (size_t)(t + 2) * kstepA; const char* b2 = last ? nB : cB + (size_t)(t + 2) * kstep;
            const char* a3 = a2 + kstepA; const char* b3 = b2 + kstep;
            if (last && has_next) S.a_ready(nxt);
            if constexpr (SP2) {
            PG8_LDB(B0, 0, 0); PG8_LDB(B1, 0, 1); PG8_SCHED; PG8_LDA(At, 0, 0); PG8_STAGE(PG8_SA(1, 1), a1 + hstep, voffA);
            PG8_WAIT_V(8); PG8_WAIT_L(0); PG8_BAR; __builtin_amdgcn_s_setprio(1); PG8_MMAQ(0, 0, At, B0); PG8_MMAQ(0, 1, At, B1); __builtin_amdgcn_s_setprio(0); PG8_BAR; PG8_SCHED;
            PG8_LDA(At, 0, 1); PG8_STAGE(PG8_SB(0, 0), b2, voffB); PG8_STAGE(PG8_SB(0, 1), b2 + hstep, voffB); PG8_STAGE(PG8_SA(0, 0), a2, voffA);
            PG8_WAIT_V(8); PG8_WAIT_L(0); PG8_BAR; __builtin_amdgcn_s_setprio(1); PG8_MMAQ(1, 0, At, B0); PG8_MMAQ(1, 1, At, B1); __builtin_amdgcn_s_setprio(0); PG8_BAR; PG8_SCHED;
            PG8_LDB(B0, 1, 0); PG8_LDB(B1, 1, 1); PG8_SCHED; PG8_LDA(At, 1, 0); PG8_STAGE(PG8_SA(0, 1), a2 + hstep, voffA);
            PG8_WAIT_V(8); PG8_WAIT_L(0); PG8_BAR; __builtin_amdgcn_s_setprio(1); PG8_MMAQ(0, 0, At, B0); PG8_MMAQ(0, 1, At, B1); __builtin_amdgcn_s_setprio(0); PG8_BAR; PG8_SCHED;
            PG8_LDA(At, 1, 1); PG8_STAGE(PG8_SB(1, 0), b3, voffB); PG8_STAGE(PG8_SB(1, 1), b3 + hstep, voffB); PG8_STAGE(PG8_SA(1, 0), a3, voffA);
            PG8_WAIT_V(8); PG8_WAIT_L(0); PG8_BAR; __builtin_amdgcn_s_setprio(1); PG8_MMAQ(1, 0, At, B0); PG8_MMAQ(1, 1, At, B1); __builtin_amdgcn_s_setprio(0); PG8_BAR; PG8_SCHED;
            } else {
            PG8_LDB(B0, 0, 0); PG8_SCHED; PG8_LDA(At, 0, 0); PG8_STAGE(PG8_SA(1, 1), a1 + hstep, voffA);
            PG8_WAIT_L(8); PG8_BAR; PG8_WAIT_L(0); PG8_MMA(0, 0, At, B0); PG8_BAR; PG8_SCHED;
            PG8_LDB(B1, 0, 1); PG8_STAGE(PG8_SB(0, 0), b2, voffB);
            PG8_BAR; PG8_WAIT_L(0); PG8_MMA(0, 1, At, B1); PG8_BAR;
            PG8_LDA(At, 0, 1); PG8_STAGE(PG8_SA(0, 0), a2, voffA);
            PG8_BAR; PG8_WAIT_L(0); PG8_MMA(1, 0, At, B0); PG8_BAR; PG8_SCHED;
            PG8_STAGE(PG8_SB(0, 1), b2 + hstep, voffB);
            PG8_WAIT_V(6); PG8_BAR; PG8_MMA(1, 1, At, B1); PG8_BAR;
            PG8_LDB(B0, 1, 0); PG8_SCHED; PG8_LDA(At, 1, 0); PG8_STAGE(PG8_SA(0, 1), a2 + hstep, voffA);
            PG8_WAIT_L(8); PG8_BAR; PG8_WAIT_L(0); PG8_MMA(0, 0, At, B0); PG8_BAR; PG8_SCHED;
            PG8_LDB(B1, 1, 1); PG8_STAGE(PG8_SB(1, 0), b3, voffB);
            PG8_BAR; PG8_WAIT_L(0); PG8_MMA(0, 1, At, B1); PG8_BAR;
            PG8_LDA(At, 1, 1); PG8_STAGE(PG8_SA(1, 0), a3, voffA);
            PG8_BAR; PG8_WAIT_L(0); PG8_MMA(1, 0, At, B0); PG8_BAR; PG8_SCHED;
            PG8_STAGE(PG8_SB(1, 1), b3 + hstep, voffB);
            PG8_WAIT_V(6); PG8_BAR; PG8_MMA(1, 1, At, B1); PG8_BAR;
            }
        }
        if constexpr (ALIGN_EPI) { if (wr == 0) PG8_BAR; }
        if constexpr (!Epi::AFTER_DRAIN) { E(acc, cur, wr, wc, fr, fq); S.done(cur); }
        if (!has_next) break;
#pragma unroll
        for (int a = 0; a < 2; ++a)
#pragma unroll
            for (int b = 0; b < 2; ++b)
#pragma unroll
                for (int m = 0; m < 4; ++m)
#pragma unroll
                    for (int n = 0; n < 2; ++n) acc[a][b][m][n] = (f32x4){0.f, 0.f, 0.f, 0.f};
        cur = nxt; cA = nA; cB = nB; ++ui;
        if constexpr (ALIGN_EPI) { if (wr == 1) PG8_BAR; }
    }
    PG8_WAIT_V(0);
    if constexpr (!ALIGN_EPI) { if (wr == 0) PG8_BAR; }
    PG8_BAR;
    if constexpr (Epi::AFTER_DRAIN) { E.fused(acc, cur, wr, wc, fr, fq, lds, wid, lane); S.done(cur); }
#undef PG8_SA
#undef PG8_SB
#undef PG8_STAGE
#undef PG8_LDA
#undef PG8_LDB
#undef PG8_MMA
#undef PG8_MMAQ
#undef PG8_WAIT_V
#undef PG8_WAIT_L
#undef PG8_BAR
#undef PG8_SCHED
}
}

#include <hip/hip_cooperative_groups.h>
#include <cstdio>
#include <cstdint>
namespace cg = cooperative_groups;
using pg8::bf16_t; using pg8::bf16x8; using pg8::f32x4; using pg8::u32x4; using pg8::cvt_pk_bf16;
typedef unsigned u32;
typedef u32 u32x2 __attribute__((ext_vector_type(2)));
typedef float f32x16 __attribute__((ext_vector_type(16)));
typedef float f32x2_t __attribute__((ext_vector_type(2)));

#ifndef MK_MULTI
#define MK_MULTI 0
#endif
#define LAS __attribute__((address_space(3)))
#define XB_TMO      128
#define XB_XCNT(j)  (256  + 64 * (j))
#define XB_XSUB(j)  (1280 + 64 * (j))
#define XB_XGEN(j)  (2304 + 64 * (j))
#define XB_TOP      3328
#define XB_TOPGEN   3392
#define XCD_BAR_WORDS 3456
#define XB_SPIN_CAP (1u << 18)

__device__ __forceinline__ unsigned xb_ld(unsigned* p)              { return __hip_atomic_load(p, __ATOMIC_RELAXED, __HIP_MEMORY_SCOPE_AGENT); }
__device__ __forceinline__ unsigned xb_add(unsigned* p, unsigned v) { return __hip_atomic_fetch_add(p, v, __ATOMIC_RELAXED, __HIP_MEMORY_SCOPE_AGENT); }
__device__ __forceinline__ unsigned xb_xcc_id() { return (unsigned)__builtin_amdgcn_s_getreg((3 << 11) | 20) & 0xFu; }
#define XB_SPIN(cond, bar) do { unsigned _sp = 0; while (cond) { __builtin_amdgcn_s_sleep(1); \
    if ((++_sp & 255u) == 0u) { if (xb_ld(&(bar)[XB_TMO])) break; if (_sp > XB_SPIN_CAP) { atomicAdd(&(bar)[XB_TMO], 1u); break; } } } } while (0)

struct XcdBarrier {
    unsigned* bar; unsigned x; unsigned G;
    volatile LAS unsigned* st;
};

__device__ __forceinline__ XcdBarrier xcd_barrier_post(unsigned* bar, volatile LAS unsigned* st, unsigned G) {
    XcdBarrier b; b.bar = bar; b.x = xb_xcc_id(); b.st = st; b.G = G;
    if (threadIdx.x == 0) (void)xb_add(&bar[XB_XCNT(b.x)], 1u);
    return b;
}
__device__ __forceinline__ void xcd_barrier_complete(unsigned* bar, unsigned x, const unsigned G, unsigned& nloc, unsigned& nx) {
    unsigned sum, cnt, mine, sp = 0u;
    for (;;) {
        sum = 0u; cnt = 0u; mine = 0u;
#pragma unroll
        for (unsigned j = 0; j < 16; ++j) { const unsigned c = xb_ld(&bar[XB_XCNT(j)]); sum += c; cnt += (c > 0u) ? 1u : 0u; mine = (j == x) ? c : mine; }
        if (sum == G) break;
        __builtin_amdgcn_s_sleep(1);
        if ((++sp & 255u) == 0u) { if (xb_ld(&bar[XB_TMO])) break; if (sp > XB_SPIN_CAP) { atomicAdd(&bar[XB_TMO], 1u); break; } }
    }
    nloc = mine > 0u ? mine : 1u; nx = cnt > 0u ? cnt : 1u;
}

__device__ __forceinline__ void xcd_barrier(const XcdBarrier& b) {
    asm volatile("s_waitcnt vmcnt(0)" ::: "memory");
    __syncthreads();
    if (threadIdx.x == 0) {
        unsigned* bar = b.bar;
        __builtin_amdgcn_s_waitcnt(0);
        unsigned nloc = b.st[0], nx = b.st[1];
        if (nloc == 0u) { xcd_barrier_complete(bar, b.x, b.G, nloc, nx); b.st[0] = nloc; b.st[1] = nx; }
        const unsigned old = xb_add(&bar[XB_XSUB(b.x)], 1u);
        const unsigned gen = old / nloc;
        if (old + 1u == (gen + 1u) * nloc) {
            __builtin_amdgcn_fence(__ATOMIC_RELEASE, "agent");
            asm volatile("s_waitcnt vmcnt(0)" ::: "memory");
            const unsigned og = xb_add(&bar[XB_TOP], 1u);
            const unsigned tg = og / nx;
            if (og + 1u == (tg + 1u) * nx) xb_add(&bar[XB_TOPGEN], 1u);
            else XB_SPIN(xb_ld(&bar[XB_TOPGEN]) == tg, bar);
            __builtin_amdgcn_fence(__ATOMIC_ACQUIRE, "agent");
            xb_add(&bar[XB_XGEN(b.x)], 1u);
            asm volatile("s_waitcnt vmcnt(0)" ::: "memory");
        } else {
            XB_SPIN(xb_ld(&bar[XB_XGEN(b.x)]) == gen, bar);
            __builtin_amdgcn_fence(__ATOMIC_ACQUIRE, "agent");
            asm volatile("s_waitcnt vmcnt(0)" ::: "memory");
        }
    }
    __syncthreads();
}


constexpr int M_TOK = 65536, DM = 1024, SEQ = 8192;
constexpr int N_PHASES = 10;
constexpr int LDS_BYTES = 147456;
constexpr float RMS_EPS = 1e-6f;

constexpr size_t MiB = 1024ull * 1024ull;
constexpr size_t WS_WIN = 0, WS_WGLU = 4 * MiB, WS_WOUT = 5 * MiB, WS_WUP = 8 * MiB, WS_WDN = 16 * MiB;
constexpr size_t WS_TWST = 24 * MiB, WS_TWOUT = 26 * MiB, WS_TKT = 28 * MiB, WS_TSC = 29 * MiB, WS_BAR = 30 * MiB;
constexpr size_t WS_SS = 31 * MiB;
constexpr size_t WS_RINV = 31 * MiB + 512 * 1024;
constexpr size_t BAR_STRIDE = 16384, BAR_BYTES = 3 * BAR_STRIDE;
constexpr int LDS_ST_OFF = 147440;
constexpr size_t WS_GROUP0 = 32 * MiB, GROUP_BYTES = 464 * MiB;
constexpr size_t G_X1B = 0  , G_SWS = 0, G_CWS = 32 * MiB, G_U3 = 48 * MiB, G_HN = 80 * MiB, G_O = 144 * MiB, G_BIG = 208 * MiB;
constexpr size_t G_PROJ = G_BIG, G_YG = G_BIG + 96 * MiB, G_YGLU = G_BIG + 128 * MiB, G_YCAT = G_BIG + 160 * MiB, G_H = G_BIG;
constexpr size_t WS_END = WS_GROUP0 + 2 * GROUP_BYTES;
constexpr int KT_ELEMS = 17 * 256, KT_PLANE = 17 * 128;
constexpr int M_HALF = M_TOK / 2;

struct Ctx { int grp, vb, GV, m0; unsigned char* wsg; };

struct Args { const float* in[21]; float* out; unsigned char* ws; int ph_lo, ph_hi; };

__device__ __forceinline__ float bf_lo(u32 w) { return __uint_as_float(w << 16); }
__device__ __forceinline__ float bf_hi(u32 w) { return __uint_as_float(w & 0xffff0000u); }
__device__ __forceinline__ bf16_t f2bf(float f) { return (bf16_t)(cvt_pk_bf16(f, 0.f) & 0xffffu); }
__device__ __forceinline__ float wave_sum(float v) {
#pragma unroll
    for (int o = 1; o < 64; o <<= 1) v += __shfl_xor(v, o);
    return v;
}
__device__ __forceinline__ float fast_rcp(float x) { return __builtin_amdgcn_rcpf(x); }
__device__ __forceinline__ float sigmoidf_(float v) { return fast_rcp(1.f + __expf(-v)); }
__device__ __forceinline__ float gelu_tanh(float v) {
    const float t = v * (-2.3022082f + -0.10294324f * (v * v)); return v * fast_rcp(1.f + __builtin_amdgcn_exp2f(t)); }

struct EpiProj {
    static constexpr bool PERM = true, AFTER_DRAIN = false;
    bf16_t* U3; bf16_t* P;
    __device__ __forceinline__ void operator()(const f32x4 (&acc)[2][2][4][2], const pg8::Unit& u, int wr, int wc, int fr, int fq) const {
        const int row0 = u.pm * 256 + wr * 64 + fr, colb = u.pn * 256 + wc * 32 + 8 * fq;
#pragma unroll
        for (int ai = 0; ai < 2; ++ai)
#pragma unroll
            for (int m = 0; m < 4; ++m) {
                const int row = row0 + ai * 128 + m * 16;
                if (u.pn >= 2 && u.pn < 6) {
                    const f32x4 h0 = acc[ai][0][m][0], c0 = acc[ai][0][m][1], h1 = acc[ai][1][m][0], c1 = acc[ai][1][m][1];
                    u32x4 z; z.x = cvt_pk_bf16(h0[0] * c0[0], h0[1] * c0[1]); z.y = cvt_pk_bf16(h0[2] * c0[2], h0[3] * c0[3]); z.z = cvt_pk_bf16(h1[0] * c1[0], h1[1] * c1[1]); z.w = cvt_pk_bf16(h1[2] * c1[2], h1[3] * c1[3]);
                    *(u32x4*)(P + (size_t)row * 1024 + (u.pn - 2) * 128 + wc * 32 + 8 * fq) = z;
                } else {
#pragma unroll
                    for (int bj = 0; bj < 2; ++bj) {
                        const int col = colb + bj * 128;
                        const f32x4 v0 = acc[ai][bj][m][0], v1 = acc[ai][bj][m][1];
                        u32x4 w; w.x = cvt_pk_bf16(v0[0], v0[1]); w.y = cvt_pk_bf16(v0[2], v0[3]); w.z = cvt_pk_bf16(v1[0], v1[1]); w.w = cvt_pk_bf16(v1[2], v1[3]);
                        if (u.pn < 2) {
                            const int b = row >> 13, tl = row & 8191, g = col >> 4, hf = (col >> 3) & 1;
                            const size_t off = (((size_t)(b * 32 + g) * 8192 + tl) * 2 + hf) * 8;
                            *(u32x4*)(U3 + off) = w;
                        } else {
                            *(u32x4*)(P + (size_t)row * 1024 + 512 + (col - 1536)) = w;
                        }
                    }
                }
            }
    }
};
template <int ACT  > struct EpiStore {
    static constexpr bool PERM = true, AFTER_DRAIN = false;
    bf16_t* O; int ldc;
    __device__ __forceinline__ void operator()(const f32x4 (&acc)[2][2][4][2], const pg8::Unit& u, int wr, int wc, int fr, int fq) const {
        const int row0 = u.pm * 256 + wr * 64 + fr, colb = u.pn * 256 + wc * 32 + 8 * fq;
#pragma unroll
        for (int ai = 0; ai < 2; ++ai)
#pragma unroll
            for (int m = 0; m < 4; ++m) {
                bf16_t* rowp = O + (size_t)(row0 + ai * 128 + m * 16) * ldc + colb;
#pragma unroll
                for (int bj = 0; bj < 2; ++bj) {
                    f32x4 v0 = acc[ai][bj][m][0], v1 = acc[ai][bj][m][1];
                    if (ACT == 1) {
#pragma unroll
                        for (int j = 0; j < 4; ++j) {
                            float a0, a1; asm("v_max_f32 %0, 0, %1" : "=v"(a0) : "v"(v0[j])); asm("v_max_f32 %0, 0, %1" : "=v"(a1) : "v"(v1[j]));
                            f32x2_t p = (f32x2_t){a0, a1}; p = p * p; v0[j] = p.x; v1[j] = p.y; }
                    }
                    u32x4 w; w.x = cvt_pk_bf16(v0[0], v0[1]); w.y = cvt_pk_bf16(v0[2], v0[3]); w.z = cvt_pk_bf16(v1[0], v1[1]); w.w = cvt_pk_bf16(v1[2], v1[3]);
                    *(u32x4*)(rowp + bj * 128) = w;
                }
            }
    }
};
template <int ACT  > struct EpiStoreBlk {
    static constexpr bool PERM = true, AFTER_DRAIN = false;
    bf16_t* O; int ldc;
    __device__ __forceinline__ void operator()(const f32x4 (&acc)[2][2][4][2], const pg8::Unit& u, int wr, int wc, int fr, int fq) const {
        const int rb0 = u.pm * 16 + wr * 4, cb0 = u.pn * 8 + wc, cbs = ldc >> 5;
#pragma unroll
        for (int ai = 0; ai < 2; ++ai)
#pragma unroll
            for (int m = 0; m < 4; ++m) {
#pragma unroll
                for (int bj = 0; bj < 2; ++bj) {
                    f32x4 v0 = acc[ai][bj][m][0], v1 = acc[ai][bj][m][1];
                    if (ACT == 1) {
#pragma unroll
                        for (int j = 0; j < 4; ++j) {
                            float a0, a1; asm("v_max_f32 %0, 0, %1" : "=v"(a0) : "v"(v0[j])); asm("v_max_f32 %0, 0, %1" : "=v"(a1) : "v"(v1[j]));
                            f32x2_t p = (f32x2_t){a0, a1}; p = p * p; v0[j] = p.x; v1[j] = p.y; }
                    }
                    u32x4 w; w.x = cvt_pk_bf16(v0[0], v0[1]); w.y = cvt_pk_bf16(v0[2], v0[3]); w.z = cvt_pk_bf16(v1[0], v1[1]); w.w = cvt_pk_bf16(v1[2], v1[3]);
                    const size_t off = (((size_t)(rb0 + ai * 8 + m) * cbs + (cb0 + bj * 4)) * 16 + fr) * 32 + 8 * fq;
                    *(u32x4*)(O + off) = w;
                }
            }
    }
};
struct EpiGlu {
    static constexpr bool PERM = true, AFTER_DRAIN = false;
    const bf16_t* Y; bf16_t* O; const float* gs; float* SS;
    __device__ __forceinline__ void operator()(const f32x4 (&acc)[2][2][4][2], const pg8::Unit& u, int wr, int wc, int fr, int fq) const {
        const int row0 = u.pm * 256 + wr * 64 + fr, colb = u.pn * 256 + wc * 32 + 8 * fq;
        f32x4 g[2][2];
#pragma unroll
        for (int bj = 0; bj < 2; ++bj) { g[bj][0] = *(const f32x4*)(gs + colb + bj * 128); g[bj][1] = *(const f32x4*)(gs + colb + bj * 128 + 4); }
#pragma unroll
        for (int ai = 0; ai < 2; ++ai)
#pragma unroll
            for (int m = 0; m < 4; ++m) {
                const int row = row0 + ai * 128 + m * 16;
                float ss = 0.f;
#pragma unroll
                for (int bj = 0; bj < 2; ++bj) {
                    const f32x4 v0 = acc[ai][bj][m][0], v1 = acc[ai][bj][m][1];
                    const u32x4 y = *(const u32x4*)(Y + (size_t)row * 512 + colb + bj * 128);
                    f32x4 t0, t1;
                    t0[0] = bf_lo(y.x) * sigmoidf_(v0[0]); t0[1] = bf_hi(y.x) * sigmoidf_(v0[1]); t0[2] = bf_lo(y.y) * sigmoidf_(v0[2]); t0[3] = bf_hi(y.y) * sigmoidf_(v0[3]);
                    t1[0] = bf_lo(y.z) * sigmoidf_(v1[0]); t1[1] = bf_hi(y.z) * sigmoidf_(v1[1]); t1[2] = bf_lo(y.w) * sigmoidf_(v1[2]); t1[3] = bf_hi(y.w) * sigmoidf_(v1[3]);
                    ss += (t0[0] * t0[0] + t0[1] * t0[1]) + (t0[2] * t0[2] + t0[3] * t0[3]) + (t1[0] * t1[0] + t1[1] * t1[1]) + (t1[2] * t1[2] + t1[3] * t1[3]);
                    t0 = t0 * g[bj][0]; t1 = t1 * g[bj][1];
                    u32x4 w; w.x = cvt_pk_bf16(t0[0], t0[1]); w.y = cvt_pk_bf16(t0[2], t0[3]); w.z = cvt_pk_bf16(t1[0], t1[1]); w.w = cvt_pk_bf16(t1[2], t1[3]);
                    *(u32x4*)(O + (size_t)row * 1024 + colb + bj * 128) = w;
                }
                ss += __shfl_xor(ss, 16); ss += __shfl_xor(ss, 32);
                if (fq == 0) unsafeAtomicAdd(SS + row, ss);
            }
    }
};

__device__ __forceinline__ void cpowd(double lrdt, double lidt, double k, float& re, float& im) {
    const double mag = exp(lrdt * k);
    double ang = lidt * k;
    ang -= 6.283185307179586476925 * rint(ang * 0.15915494309189533577);
    re = (float)(mag * cos(ang)); im = (float)(mag * sin(ang));
}
__device__ __forceinline__ void transpose_item(const float* W, int K, int N, bf16_t* WT, float* scr, int item, int lane, const float* gk = nullptr, bool win_map = false) {
    const int nblk = N / 32, kb = item / nblk, nb = item % nblk, k0 = 64 * kb, n0 = 32 * nb;
#pragma unroll 8
    for (int i = 0; i < 32; ++i) { const int kk = 2 * i + (lane >> 5); float w = W[(size_t)(k0 + kk) * N + n0 + (lane & 31)]; if (gk) w *= gk[k0 + kk]; scr[kk * 33 + (lane & 31)] = w; }
    __builtin_amdgcn_s_waitcnt(0xc07f); asm volatile("" ::: "memory");
    const int c = lane & 7;
#pragma unroll
    for (int j = 0; j < 4; ++j) { const int n = (lane >> 3) + 8 * j; const float* s = scr + (8 * c) * 33 + n;
        u32x4 o; o.x = cvt_pk_bf16(s[0 * 33], s[1 * 33]); o.y = cvt_pk_bf16(s[2 * 33], s[3 * 33]); o.z = cvt_pk_bf16(s[4 * 33], s[5 * 33]); o.w = cvt_pk_bf16(s[6 * 33], s[7 * 33]);
        int nr = n0 + n;
        if (win_map && nr >= 512) {
            if (nr < 1024 || nr >= 1536) { const int nn = nr >= 1536, ch = nr - (nn ? 1536 : 512), r = ch & 127;
                nr = 512 + 256 * (ch >> 7) + 128 * ((r >> 2) & 1) + 32 * (r >> 5) + 8 * ((r >> 3) & 3) + 4 * nn + (r & 3); }
            else nr = nr + 512;
        }
        *(u32x4*)(WT + (size_t)nr * K + k0 + 8 * c) = o; }
    __builtin_amdgcn_s_waitcnt(0xc07f); asm volatile("" ::: "memory");
}
__device__ __forceinline__ void phase_prep_w(const Args& a, const Ctx& c, unsigned char* lds) {
    const int tid = threadIdx.x, lane = tid & 63, wave = tid >> 6;
    const int gw = c.vb * 8 + wave, NGW = c.GV * 8;
    unsigned char* ws = a.ws;
    {
        const float* lam_re = a.in[3]; const float* lam_im = a.in[4]; const float* log_dt = a.in[5];
        const float* b_re = a.in[6]; const float* b_im = a.in[7]; const float* c_re = a.in[8]; const float* c_im = a.in[9]; const float* d_skip = a.in[10];
        float2* shpow = (float2*)(lds + 69632);
        float2* shcoef = (float2*)(lds + 69632 + 6144);
        float2* shB = (float2*)(lds + 69632 + 8192);
        float2* shC = (float2*)(lds + 69632 + 16384);
        bf16_t* TWST = (bf16_t*)(ws + WS_TWST); bf16_t* TWOUT = (bf16_t*)(ws + WS_TWOUT); bf16_t* TKT = (bf16_t*)(ws + WS_TKT); float4* TSC = (float4*)(ws + WS_TSC);
        for (int it = c.vb; it < 128; it += c.GV) {
            const int g = it >> 2, jq = it & 3;
            if (tid < 256) {
                const int p = tid & 63, jj = tid >> 6, j = 4 * jq + jj;
                const double dt = exp((double)log_dt[g]);
                const double lr = (double)lam_re[g * 64 + p], li = (double)lam_im[g * 64 + p];
                const double lrdt = lr * dt, lidt = li * dt;
                const double mag = exp(lrdt); double ang = lidt; ang -= 6.283185307179586476925 * rint(ang * 0.15915494309189533577);
                const double a1r = mag * cos(ang), a1i = mag * sin(ang);
                double pjr = 1.0, pji = 0.0, pqr = 1.0, pqi = 0.0;
                for (int k = 0; k < j; ++k) { const double t = pjr * a1r - pji * a1i; pji = pjr * a1i + pji * a1r; pjr = t; }
                for (int k = 0; k < 15 - j; ++k) { const double t = pqr * a1r - pqi * a1i; pqi = pqr * a1i + pqi * a1r; pqr = t; }
                const double p1r = pjr * a1r - pji * a1i, p1i = pjr * a1i + pji * a1r;
                shpow[(jj * 3 + 0) * 64 + p] = make_float2((float)pjr, (float)pji); shpow[(jj * 3 + 1) * 64 + p] = make_float2((float)pqr, (float)pqi); shpow[(jj * 3 + 2) * 64 + p] = make_float2((float)p1r, (float)p1i);
                if (jj == 0) {
                    const double nr = a1r - 1.0, ni = a1i, den = lr * lr + li * li;
                    shcoef[p] = make_float2((float)((nr * lr + ni * li) / den), (float)((ni * lr - nr * li) / den));
                    if (jq == 0) {
                        const double s16r = p1r * pqr - p1i * pqi, s16i = p1r * pqi + p1i * pqr;
                        double br = s16r, bi = s16i;
#pragma unroll
                        for (int k = 0; k < 6; ++k) { const double t = br * br - bi * bi; bi = 2.0 * br * bi; br = t; }
                        TSC[g * 64 + p] = make_float4((float)s16r, (float)s16i, (float)br, (float)bi);
                    }
                }
            }
            __syncthreads();
#pragma unroll
            for (int i = 0; i < 2; ++i) {
                const int e = tid + 512 * i;
                { const int p = e >> 4; const float2 co = shcoef[p]; const float br = b_re[g * 1024 + e], bi = b_im[g * 1024 + e]; shB[e] = make_float2(co.x * br - co.y * bi, co.x * bi + co.y * br); }
                shC[e] = make_float2(c_re[g * 1024 + e], c_im[g * 1024 + e]);
            }
            __syncthreads();
#pragma unroll
            for (int i = 0; i < 2; ++i) {
                const int e = tid + 512 * i, jj = e >> 8, hp = (e >> 4) & 15, h = e & 15, j = 4 * jq + jj; float val = 0.f;
#pragma unroll 8
                for (int p = 0; p < 64; ++p) {
                    const float2 A = shpow[(jj * 3 + 0) * 64 + p], bb = shB[p * 16 + h], cc = shC[hp * 64 + p];
                    const float tr = A.x * bb.x - A.y * bb.y, ti = A.x * bb.y + A.y * bb.x;
                    val += cc.x * tr - cc.y * ti;
                }
                if (j == 0 && hp == h) val += d_skip[g * 16 + hp];
                TKT[(size_t)g * KT_ELEMS + (h >> 3) * KT_PLANE + (1 + j) * 128 + hp * 8 + (h & 7)] = f2bf(val);
                if (jq == 0 && e < 256) TKT[(size_t)g * KT_ELEMS + (e >> 7) * KT_PLANE + (e & 127)] = 0;
            }
#pragma unroll 1
            for (int jj = 0; jj < 4; ++jj) {
                const int j = 4 * jq + jj;
#pragma unroll
                for (int i = 0; i < 4; ++i) {
                    const int e = tid + 512 * i;
                    {
                        const int h = e & 15, col = e >> 4, cidx = col >> 6, p = col & 63;
                        const float2 A = shpow[(jj * 3 + 1) * 64 + p], bb = shB[p * 16 + h];
                        const float tr = A.x * bb.x - A.y * bb.y, ti = A.x * bb.y + A.y * bb.x;
                        TWST[(size_t)g * 32768 + j * 2048 + (col >> 5) * 512 + (h >> 3) * 256 + (col & 31) * 8 + (h & 7)] = f2bf(cidx ? ti : tr);
                    }
                    {
                        const int hp = e & 15, p = (e >> 4) & 63, cidx = e >> 10;
                        const float2 A = shpow[(jj * 3 + 2) * 64 + p], cc = shC[hp * 64 + p];
                        const float tr = cc.x * A.x - cc.y * A.y, ti = cc.x * A.y + cc.y * A.x;
                        const int ni = j >> 1, n = (j & 1) * 16 + hp, kk = cidx * 4 + (p >> 4), k = p & 15;
                        TWOUT[(size_t)g * 32768 + (kk * 8 + ni) * 512 + (k >> 3) * 256 + n * 8 + (k & 7)] = f2bf(cidx ? -ti : tr);
                    }
                }
            }
            __syncthreads();
        }
    }
    {
        float* scr = (float*)(lds + wave * 8448);
        constexpr int I_IN = 16 * 64, I_GLU = 8 * 16, I_OUT = 16 * 32, I_UP = 16 * 128, I_DN = 64 * 32;
        constexpr int NITEMS = I_IN + I_GLU + I_OUT + I_UP + I_DN;
        for (int it = gw; it < NITEMS; it += NGW) {
            int r = it;
            if (r < I_IN) { transpose_item(a.in[2], 1024, 2048, (bf16_t*)(ws + WS_WIN), scr, r, lane, nullptr, true); continue; } r -= I_IN;
            if (r < I_GLU) { transpose_item(a.in[11], 512, 512, (bf16_t*)(ws + WS_WGLU), scr, r, lane); continue; } r -= I_GLU;
            if (r < I_OUT) { transpose_item(a.in[15], 1024, 1024, (bf16_t*)(ws + WS_WOUT), scr, r, lane); continue; } r -= I_OUT;
            if (r < I_UP) { transpose_item(a.in[18], 1024, 4096, (bf16_t*)(ws + WS_WUP), scr, r, lane, a.in[17]); continue; } r -= I_UP;
            transpose_item(a.in[19], 4096, 1024, (bf16_t*)(ws + WS_WDN), scr, r, lane);
        }
    }
}
__device__ __forceinline__ float pair_sum(float v) {
    v += __shfl_xor(v, 1); v += __shfl_xor(v, 2); v += __shfl_xor(v, 4); v += __shfl_xor(v, 16); v += __shfl_xor(v, 32); return v;
}
__device__ __forceinline__ void phase_xnorm(const Args& a, const Ctx& c) {
    const int tid = threadIdx.x, lane = tid & 63, wave = tid >> 6;
    const int gw = c.vb * 8 + wave, NGW = c.GV * 8;
    { float* SS = (float*)(a.ws + WS_SS) + (size_t)c.grp * M_HALF; for (int i = c.vb * 512 + tid; i < M_HALF; i += c.GV * 512) SS[i] = 0.f; }
    const float* x = a.in[0] + (size_t)c.m0 * DM; const float* gp = a.in[1]; bf16_t* HN = (bf16_t*)(c.wsg + G_HN); float* RINV = (float*)(a.ws + WS_RINV) + (size_t)c.grp * M_HALF;
    const int sub = (lane >> 3) & 1, cl = 32 * (lane >> 4) + 4 * (lane & 7);
    f32x4 gv[8];
#pragma unroll
    for (int j = 0; j < 8; ++j) gv[j] = *(const f32x4*)(gp + cl + 128 * j);
    f32x4 v[8], nx[8];
#pragma unroll
    for (int j = 0; j < 8; ++j) v[j] = __builtin_nontemporal_load((const f32x4*)(x + (size_t)(2 * gw + sub) * DM + cl + 128 * j));
    for (int pr = gw; pr < M_HALF / 2; pr += NGW) {
        const int pn = pr + NGW, r = 2 * pr;
        if (pn < M_HALF / 2) {
#pragma unroll
            for (int j = 0; j < 8; ++j) nx[j] = __builtin_nontemporal_load((const f32x4*)(x + (size_t)(2 * pn + sub) * DM + cl + 128 * j));
        }
        float ss = 0.f;
#pragma unroll
        for (int j = 0; j < 8; ++j) ss += (v[j].x * v[j].x + v[j].y * v[j].y) + (v[j].z * v[j].z + v[j].w * v[j].w);
        const float q = pair_sum(ss) * (1.f / DM) + RMS_EPS, rr = rsqrtf(q);
        if ((lane & 0x37) == 0) RINV[r + sub] = q * rr;
        bf16_t* hb = HN + (size_t)(r >> 4) * 16384 + (r & 15) * 32 + (lane >> 4) * 512 + (lane & 15) * 4;
#pragma unroll
        for (int j = 0; j < 8; ++j) {
            u32x2 o; o.x = cvt_pk_bf16(v[j].x * rr * gv[j].x, v[j].y * rr * gv[j].y); o.y = cvt_pk_bf16(v[j].z * rr * gv[j].z, v[j].w * rr * gv[j].w);
            *(u32x2*)(hb + j * 2048) = o;
        }
#pragma unroll
        for (int j = 0; j < 8; ++j) v[j] = nx[j];
    }
}

__device__ __forceinline__ f32x16 mfma32(bf16x8 a, bf16x8 b, f32x16 c) { return __builtin_amdgcn_mfma_f32_32x32x16_bf16(a, b, c, 0, 0, 0); }
__device__ __forceinline__ void phase_ssm(const Args& a, const Ctx& c, unsigned char* ldsg) {
    const int tid = threadIdx.x, lane = tid & 63, wave = __builtin_amdgcn_readfirstlane(tid >> 6);
    unsigned char* ws = a.ws;
    const bf16_t* lw = (const bf16_t*)ldsg;
    float2* shE = (float2*)(ldsg + 139776);
    const bf16_t* U3 = (const bf16_t*)(c.wsg + G_U3);
    bf16_t* YG = (bf16_t*)(c.wsg + G_YG);
    const float4* TSC = (const float4*)(ws + WS_TSC);
    const int boff = (lane >> 5) * 256 + (lane & 31) * 8;
    const int koff = (lane >> 5) * KT_PLANE + (lane & 31) * 8;
    for (int item = c.vb; item < 128; item += c.GV) {
        const int b = item >> 5, g = item & 31;
        {
            const u32x4* s0 = (const u32x4*)(ws + WS_TWST + (size_t)g * 65536); u32x4* d0 = (u32x4*)ldsg;
            const u32x4* s1 = (const u32x4*)(ws + WS_TWOUT + (size_t)g * 65536); u32x4* d1 = (u32x4*)(ldsg + 65536);
            const u32x4* s2 = (const u32x4*)(ws + WS_TKT + (size_t)g * (KT_ELEMS * 2)); u32x4* d2 = (u32x4*)(ldsg + 131072);
#pragma unroll
            for (int i = 0; i < 8; ++i) { d0[tid + 512 * i] = s0[tid + 512 * i]; d1[tid + 512 * i] = s1[tid + 512 * i]; }
            for (int i = tid; i < (KT_ELEMS * 2) / 16; i += 512) d2[i] = s2[i];
        }
        __syncthreads();
        const bf16_t* Ubg = U3 + (size_t)item * 131072;
        const bf16_t* Ul = Ubg + (lane & 31) * 256 + (lane >> 5) * 8;
        float* Sw = (float*)(c.wsg + G_SWS) + (size_t)item * 65536;
        bf16_t* Cw = (bf16_t*)(c.wsg + G_CWS) + (size_t)item * 65536;
        for (int q = 0; q < 2; ++q) {
            const int mb = wave * 2 + q;
            bf16x8 ua[16];
#pragma unroll
            for (int s = 0; s < 16; ++s) ua[s] = *(const bf16x8*)(Ul + mb * 8192 + s * 16);
#pragma unroll 1
            for (int nb = 0; nb < 4; ++nb) {
                f32x16 acc;
#pragma unroll
                for (int r = 0; r < 16; ++r) acc[r] = 0.f;
#pragma unroll
                for (int s = 0; s < 16; ++s) { const bf16x8 B = *(const bf16x8*)(lw + (s * 4 + nb) * 512 + boff); acc = mfma32(ua[s], B, acc); }
#pragma unroll
                for (int r = 0; r < 16; ++r) { const int row = (r & 3) + 8 * (r >> 2) + 4 * (lane >> 5); Sw[(size_t)(mb * 32 + row) * 128 + nb * 32 + (lane & 31)] = acc[r]; }
            }
        }
        __builtin_amdgcn_fence(__ATOMIC_RELEASE, "workgroup"); asm volatile("s_waitcnt vmcnt(0)" ::: "memory"); __builtin_amdgcn_fence(__ATOMIC_ACQUIRE, "workgroup");
        {
            const float4 sc = TSC[g * 64 + lane];
            const float* Sp = Sw + (size_t)(wave * 64) * 128 + lane;
            float sr[32], si[32];
            float xr = 0.f, xi = 0.f;
#pragma unroll 1
            for (int hb = 0; hb < 2; ++hb) {
#pragma unroll
                for (int n = 0; n < 32; ++n) { sr[n] = Sp[(hb * 32 + n) * 128]; si[n] = Sp[(hb * 32 + n) * 128 + 64]; }
#pragma unroll
                for (int n = 0; n < 32; ++n) { const float nr = sc.x * xr - sc.y * xi + sr[n], ni = sc.x * xi + sc.y * xr + si[n]; xr = nr; xi = ni; }
            }
            shE[wave * 64 + lane] = make_float2(xr, xi);
            __syncthreads();
            xr = 0.f; xi = 0.f;
            for (int v = 0; v < wave; ++v) { const float2 e = shE[v * 64 + lane]; const float nr = sc.z * xr - sc.w * xi + e.x, ni = sc.z * xi + sc.w * xr + e.y; xr = nr; xi = ni; }
            bf16_t* Cp = Cw + (size_t)(wave * 64) * 128 + lane;
#pragma unroll 1
            for (int hb = 0; hb < 2; ++hb) {
#pragma unroll
                for (int n = 0; n < 32; ++n) { sr[n] = Sp[(hb * 32 + n) * 128]; si[n] = Sp[(hb * 32 + n) * 128 + 64]; }
#pragma unroll
                for (int n = 0; n < 32; ++n) {
                    Cp[(hb * 32 + n) * 128] = f2bf(xr); Cp[(hb * 32 + n) * 128 + 64] = f2bf(xi);
                    const float nr = sc.x * xr - sc.y * xi + sr[n], ni = sc.x * xi + sc.y * xr + si[n]; xr = nr; xi = ni;
                }
            }
        }
        __builtin_amdgcn_fence(__ATOMIC_RELEASE, "workgroup"); asm volatile("s_waitcnt vmcnt(0)" ::: "memory"); __builtin_amdgcn_fence(__ATOMIC_ACQUIRE, "workgroup");
        for (int q = 0; q < 2; ++q) {
            const int mb = wave * 2 + q;
            bf16x8 ua[16], ca[8];
#pragma unroll
            for (int s = 0; s < 16; ++s) ua[s] = *(const bf16x8*)(Ul + mb * 8192 + s * 16);
#pragma unroll
            for (int kk = 0; kk < 8; ++kk) ca[kk] = *(const bf16x8*)(Cw + (size_t)(mb * 32 + (lane & 31)) * 128 + kk * 16 + (lane >> 5) * 8);
#pragma unroll 1
            for (int ni = 0; ni < 8; ++ni) {
                f32x16 acc;
#pragma unroll
                for (int r = 0; r < 16; ++r) acc[r] = 0.f;
#pragma unroll
                for (int s = 0; s < 16; ++s) if (s <= 2 * ni + 1) { const bf16x8 B = *(const bf16x8*)(lw + 65536 + (2 * ni - s + 1) * 128 + koff); acc = mfma32(ua[s], B, acc); }
#pragma unroll
                for (int kk = 0; kk < 8; ++kk) { const bf16x8 B = *(const bf16x8*)(lw + 32768 + (kk * 8 + ni) * 512 + boff); acc = mfma32(ca[kk], B, acc); }
                const int tau = 2 * ni + ((lane & 31) >> 4), hp = lane & 15;
#pragma unroll
                for (int r = 0; r < 16; ++r) {
                    const int row = (r & 3) + 8 * (r >> 2) + 4 * (lane >> 5);
                    const int tl = (mb * 32 + row) * 16 + tau;
                    YG[((size_t)(b * SEQ + tl)) * 512 + g * 16 + hp] = f2bf(gelu_tanh(acc[r]));
                }
            }
        }
        __syncthreads();
    }
}

__device__ __forceinline__ void unpack8(const u32x4 w, float (&f)[8]) { f[0] = bf_lo(w.x); f[1] = bf_hi(w.x); f[2] = bf_lo(w.y); f[3] = bf_hi(w.y); f[4] = bf_lo(w.z); f[5] = bf_hi(w.z); f[6] = bf_lo(w.w); f[7] = bf_hi(w.w); }
__device__ __forceinline__ u32x4 pack8(const float (&f)[8]) { u32x4 w; w.x = cvt_pk_bf16(f[0], f[1]); w.y = cvt_pk_bf16(f[2], f[3]); w.z = cvt_pk_bf16(f[4], f[5]); w.w = cvt_pk_bf16(f[6], f[7]); return w; }
__device__ __forceinline__ void phase_mix(const Args& a, const Ctx& c) {
    const int tid = threadIdx.x, lane = tid & 63, wave = tid >> 6;
    const int gw = c.vb * 8 + wave, NGW = c.GV * 8;
    const bf16_t* P = (const bf16_t*)(c.wsg + G_PROJ); bf16_t* YCAT = (bf16_t*)(c.wsg + G_YCAT); const float* SS = (const float*)(a.ws + WS_SS) + (size_t)c.grp * M_HALF;
    const float* cw = a.in[12]; const float* gc = a.in[14];
    const int j0 = 8 * lane;
    float w0[8], w1[8], w2[8], gcv[8];
#pragma unroll
    for (int j = 0; j < 8; ++j) { w0[j] = cw[j0 + j]; w1[j] = cw[512 + j0 + j]; w2[j] = cw[1024 + j0 + j]; gcv[j] = gc[j0 + j]; }
    constexpr int STRIP = 32;
    for (int st = gw; st < M_HALF / STRIP; st += NGW) {
        const int row0 = st * STRIP;
        float zp2[8], zp1[8];
        if ((row0 & (SEQ - 1)) == 0) {
#pragma unroll
            for (int j = 0; j < 8; ++j) { zp2[j] = 0.f; zp1[j] = 0.f; }
        } else {
            unpack8(*(const u32x4*)(P + (size_t)(row0 - 2) * 1024 + j0), zp2);
            unpack8(*(const u32x4*)(P + (size_t)(row0 - 1) * 1024 + j0), zp1);
        }
        constexpr int PR = 4;
        u32x4 lz[PR], lb[PR], nz[PR], nb[PR]; float ly[PR], ny[PR];
#pragma unroll
        for (int k = 0; k < PR; ++k) { const size_t r = (size_t)(row0 + k); lz[k] = *(const u32x4*)(P + r * 1024 + j0); lb[k] = *(const u32x4*)(P + r * 1024 + 512 + j0); ly[k] = SS[r]; }
        for (int i = 0; i < STRIP; i += PR) {
            if (i + PR < STRIP) {
#pragma unroll
                for (int k = 0; k < PR; ++k) { const size_t r = (size_t)(row0 + i + PR + k); nz[k] = *(const u32x4*)(P + r * 1024 + j0); nb[k] = *(const u32x4*)(P + r * 1024 + 512 + j0); ny[k] = SS[r]; }
            }
#pragma unroll
            for (int k = 0; k < PR; ++k) {
                const int row = row0 + i + k;
                float bg[8], z[8], yc[8];
                unpack8(lz[k], z); unpack8(lb[k], bg);
                float ssc = 0.f;
#pragma unroll
                for (int j = 0; j < 8; ++j) { yc[j] = bg[j] * (w0[j] * zp2[j] + w1[j] * zp1[j] + w2[j] * z[j]); ssc += yc[j] * yc[j]; }
                ssc = wave_sum(ssc);
                const float rc = rsqrtf(ssc * (1.f / 512.f) + RMS_EPS) * sqrtf(ly[k] * (1.f / 512.f) + RMS_EPS);
#pragma unroll
                for (int j = 0; j < 8; ++j) { yc[j] = yc[j] * rc * gcv[j]; zp2[j] = zp1[j]; zp1[j] = z[j]; }
                *(u32x4*)(YCAT + (size_t)row * 1024 + 512 + j0) = pack8(yc);
            }
#pragma unroll
            for (int k = 0; k < PR; ++k) { lz[k] = nz[k]; lb[k] = nb[k]; ly[k] = ny[k]; }
        }
    }
}

__device__ __forceinline__ void phase_resid6(const Args& a, const Ctx& c) {
    const int tid = threadIdx.x, lane = tid & 63, wave = tid >> 6;
    const int gw = c.vb * 8 + wave, NGW = c.GV * 8;
    const bf16_t* HN = (const bf16_t*)(c.wsg + G_HN); const float* RINV = (const float*)(a.ws + WS_RINV) + (size_t)c.grp * M_HALF;
    const bf16_t* O = (const bf16_t*)(c.wsg + G_O); bf16_t* X1B = (bf16_t*)(c.wsg + G_X1B);
    const float* SS = (const float*)(a.ws + WS_SS) + (size_t)c.grp * M_HALF;
    const int sub = (lane >> 3) & 1, cl = 32 * (lane >> 4) + 4 * (lane & 7), lo = (lane >> 4) * 512 + (lane & 15) * 4;
    f32x4 g1[8], gi[8];
#pragma unroll
    for (int j = 0; j < 8; ++j) { g1[j] = *(const f32x4*)(a.in[16] + cl + 128 * j); const f32x4 g0 = *(const f32x4*)(a.in[1] + cl + 128 * j); gi[j] = (f32x4){1.f / g0.x, 1.f / g0.y, 1.f / g0.z, 1.f / g0.w}; }
    u32x2 xv[8], nxv[8], ov[8], nov[8]; float ssv, nssv = 0.f, riv, nriv = 0.f;
    { const int r = 2 * gw; const size_t bo = (size_t)(r >> 4) * 16384 + (r & 15) * 32 + lo; ssv = SS[r + sub]; riv = RINV[r + sub];
#pragma unroll
      for (int j = 0; j < 8; ++j) { xv[j] = *(const u32x2*)(HN + bo + j * 2048); ov[j] = *(const u32x2*)(O + bo + j * 2048); } }
    for (int pr = gw; pr < M_HALF / 2; pr += NGW) {
        const int pn = pr + NGW, r = 2 * pr;
        if (pn < M_HALF / 2) { const int rn = 2 * pn; const size_t bo = (size_t)(rn >> 4) * 16384 + (rn & 15) * 32 + lo; nssv = SS[rn + sub]; nriv = RINV[rn + sub];
#pragma unroll
            for (int j = 0; j < 8; ++j) { nxv[j] = *(const u32x2*)(HN + bo + j * 2048); nov[j] = *(const u32x2*)(O + bo + j * 2048); } }
        f32x4 of[8]; float so = 0.f;
#pragma unroll
        for (int j = 0; j < 8; ++j) { of[j] = (f32x4){bf_lo(ov[j].x), bf_hi(ov[j].x), bf_lo(ov[j].y), bf_hi(ov[j].y)}; so += (of[j].x * of[j].x + of[j].y * of[j].y) + (of[j].z * of[j].z + of[j].w * of[j].w); }
        const float ro = rsqrtf(pair_sum(so) * (1.f / DM) + RMS_EPS * (ssv * (1.f / 512.f) + RMS_EPS));
        bf16_t* xb = X1B + (size_t)(r >> 4) * 16384 + (r & 15) * 32 + lo;
#pragma unroll
        for (int j = 0; j < 8; ++j) {
            const f32x4 xr = (f32x4){bf_lo(xv[j].x), bf_hi(xv[j].x), bf_lo(xv[j].y), bf_hi(xv[j].y)} * gi[j] * riv;
            const f32x4 x1 = xr + of[j] * ro * g1[j];
            u32x2 q; q.x = cvt_pk_bf16(x1.x, x1.y); q.y = cvt_pk_bf16(x1.z, x1.w); *(u32x2*)(xb + j * 2048) = q;
        }
#pragma unroll
        for (int j = 0; j < 8; ++j) { xv[j] = nxv[j]; ov[j] = nov[j]; }
        ssv = nssv; riv = nriv;
    }
}
__device__ __forceinline__ void phase_final(const Args& a, const Ctx& c, int tg, int p_lo, int p_hi) {
    const int tid = threadIdx.x, lane = tid & 63, wave = tid >> 6;
    const int gw = p_lo + c.vb * 8 + wave, NGW = c.GV * 8;
    if (gw >= p_hi) return;
    float* outp = a.out + (size_t)tg * M_HALF * DM;
    const unsigned char* wst = a.ws + WS_GROUP0 + (size_t)tg * GROUP_BYTES;
    const bf16_t* MO = (const bf16_t*)(wst + G_HN); const bf16_t* X1B = (const bf16_t*)(wst + G_X1B);
    const int sub = (lane >> 3) & 1, cl = 32 * (lane >> 4) + 4 * (lane & 7), lo = (lane >> 4) * 512 + (lane & 15) * 4;
    f32x4 g2[8];
#pragma unroll
    for (int j = 0; j < 8; ++j) g2[j] = *(const f32x4*)(a.in[20] + cl + 128 * j);
    u32x2 xv[8], nxv[8], mv[8], nmv[8];
    { const int r = 2 * gw; const size_t bo = (size_t)(r >> 4) * 16384 + (r & 15) * 32 + lo;
#pragma unroll
      for (int j = 0; j < 8; ++j) { xv[j] = *(const u32x2*)(X1B + bo + j * 2048); mv[j] = *(const u32x2*)(MO + bo + j * 2048); } }
    for (int pr = gw; pr < p_hi; pr += NGW) {
        const int pn = pr + NGW, r = 2 * pr;
        if (pn < p_hi) { const int rn = 2 * pn; const size_t bo = (size_t)(rn >> 4) * 16384 + (rn & 15) * 32 + lo;
#pragma unroll
            for (int j = 0; j < 8; ++j) { nxv[j] = *(const u32x2*)(X1B + bo + j * 2048); nmv[j] = *(const u32x2*)(MO + bo + j * 2048); } }
        f32x4 mf[8], x1[8]; float sm = 0.f, s1 = 0.f;
#pragma unroll
        for (int j = 0; j < 8; ++j) { mf[j] = (f32x4){bf_lo(mv[j].x), bf_hi(mv[j].x), bf_lo(mv[j].y), bf_hi(mv[j].y)};
            x1[j] = (f32x4){bf_lo(xv[j].x), bf_hi(xv[j].x), bf_lo(xv[j].y), bf_hi(xv[j].y)};
            sm += (mf[j].x * mf[j].x + mf[j].y * mf[j].y) + (mf[j].z * mf[j].z + mf[j].w * mf[j].w);
            s1 += (x1[j].x * x1[j].x + x1[j].y * x1[j].y) + (x1[j].z * x1[j].z + x1[j].w * x1[j].w); }
        sm = pair_sum(sm); s1 = pair_sum(s1);
        const float q1 = s1 * (1.f / DM) + RMS_EPS;
        const float rm = rsqrtf(sm * (1.f / DM) + RMS_EPS * q1 * q1);
        float* ob = outp + (size_t)(r + sub) * DM + cl;
#pragma unroll
        for (int j = 0; j < 8; ++j) __builtin_nontemporal_store(x1[j] + mf[j] * rm * g2[j], (f32x4*)(ob + 128 * j));
#pragma unroll
        for (int j = 0; j < 8; ++j) { xv[j] = nxv[j]; mv[j] = nmv[j]; }
    }
}

template <class Epi, bool ABLK = false> __device__ __forceinline__ void run_gemm(unsigned char* lds, const Ctx& c, const bf16_t* A, const bf16_t* Bt, int N, int K, const Epi& E, int rev = 0) {
    pg8::StaticOrder S; S.init(M_HALF, N, c.GV, c.vb, 4, rev);
    pg8::gemm_phase<Epi, pg8::StaticOrder, true, true, ABLK>((PG8_LAS unsigned char*)lds, pg8::Gemm{A, Bt, M_HALF, N, K}, S, E);
}
#ifdef PROBE_DUMMY
struct ProbeOrder : pg8::StaticOrder {
    int mode;
    __device__ bool next(int i, pg8::Unit& u) const { if (mode) { if (i >= 16) return false; u.pm = 0; u.pn = 0; return true; } return pg8::StaticOrder::next(i, u); }
};
#endif
__global__ void __launch_bounds__(512, 2) hymba_fwd(Args a) {
    extern __shared__ __attribute__((aligned(16))) unsigned char lds[];
    Ctx c;
    c.GV = (int)gridDim.x >> 1; c.grp = ((int)blockIdx.x & 7) >> 2; c.vb = (((int)blockIdx.x >> 3) << 2) | ((int)blockIdx.x & 3);
    c.m0 = c.grp * M_HALF; c.wsg = a.ws + WS_GROUP0 + (size_t)c.grp * GROUP_BYTES;
    unsigned char* ws = a.ws; unsigned char* wsg = c.wsg;
    volatile LAS unsigned* st = (volatile LAS unsigned*)((LAS unsigned char*)lds + LDS_ST_OFF);
    if (threadIdx.x < 4) st[threadIdx.x] = 0u;
    __syncthreads();
    const XcdBarrier gb = xcd_barrier_post((unsigned*)(ws + WS_BAR + (size_t)c.grp * BAR_STRIDE), st, (unsigned)c.GV);
    unsigned* wready = (unsigned*)(ws + WS_BAR + 2 * BAR_STRIDE);
    if (a.ph_lo < 0) cg::this_grid().sync();
    if (c.grp == 1) {
        phase_prep_w(a, c, lds);
#if defined(PROBE_X2) && (PROBE_X2 & 1)
        __syncthreads(); phase_prep_w(a, c, lds);
#endif
        asm volatile("s_waitcnt vmcnt(0)" ::: "memory");
        __syncthreads();
        if (threadIdx.x == 0) {
            __builtin_amdgcn_fence(__ATOMIC_RELEASE, "agent");
            asm volatile("s_waitcnt vmcnt(0)" ::: "memory");
            (void)__hip_atomic_fetch_add(wready, 1u, __ATOMIC_RELAXED, __HIP_MEMORY_SCOPE_AGENT);
        }
        phase_xnorm(a, c);
    } else {
        phase_xnorm(a, c);
        if (threadIdx.x == 0) {
            unsigned sp = 0;
            while (__hip_atomic_load(wready, __ATOMIC_RELAXED, __HIP_MEMORY_SCOPE_AGENT) < (unsigned)c.GV) { __builtin_amdgcn_s_sleep(2); if (++sp > (1u << 22)) break; }
            __builtin_amdgcn_fence(__ATOMIC_ACQUIRE, "agent");
            asm volatile("s_waitcnt vmcnt(0)" ::: "memory");
        }
        __syncthreads();
    }
    xcd_barrier(gb);
    run_gemm<EpiProj, true>(lds, c, (const bf16_t*)(wsg + G_HN), (const bf16_t*)(ws + WS_WIN), 2048, 1024, EpiProj{(bf16_t*)(wsg + G_U3), (bf16_t*)(wsg + G_PROJ)});
    xcd_barrier(gb);
    phase_ssm(a, c, lds);
    xcd_barrier(gb);
    run_gemm(lds, c, (const bf16_t*)(wsg + G_YG), (const bf16_t*)(ws + WS_WGLU), 512, 512, EpiGlu{(const bf16_t*)(wsg + G_YG), (bf16_t*)(wsg + G_YCAT), a.in[13], (float*)(ws + WS_SS) + (size_t)c.grp * M_HALF});
    xcd_barrier(gb);
    phase_mix(a, c);
#if defined(PROBE_X2) && (PROBE_X2 & 2)
    if (c.grp == 1) phase_mix(a, c);
#endif
    xcd_barrier(gb);
    run_gemm(lds, c, (const bf16_t*)(wsg + G_YCAT), (const bf16_t*)(ws + WS_WOUT), 1024, 1024, EpiStoreBlk<0>{(bf16_t*)(wsg + G_O), 1024});
    xcd_barrier(gb);
    phase_resid6(a, c);
#if defined(PROBE_X2) && (PROBE_X2 & 2)
    if (c.grp == 1) phase_resid6(a, c);
#endif
    xcd_barrier(gb);
#ifdef PROBE_DUMMY
#pragma unroll 1
    for (int rp = 0; rp < 2; ++rp) {
        ProbeOrder S; S.init(M_HALF, 4096, c.GV, c.vb, 4); S.mode = rp;
        EpiStore<1> E{rp ? (bf16_t*)(ws + WS_END) : (bf16_t*)(wsg + G_H), 4096};
        pg8::gemm_phase<EpiStore<1>, ProbeOrder, true, true>((PG8_LAS unsigned char*)lds, pg8::Gemm{(const bf16_t*)(wsg + G_X1B), (const bf16_t*)(ws + WS_WUP), M_HALF, 4096, 1024}, S, E);
        xcd_barrier(gb);
    }
#elif defined(PROBE_UP2)
#pragma unroll 1
    for (int rp = 0; rp < (c.grp == 1 ? 2 : 1); ++rp) {
        run_gemm(lds, c, (const bf16_t*)(wsg + G_X1B), (const bf16_t*)(ws + WS_WUP), 4096, 1024, EpiStore<1>{(bf16_t*)(wsg + G_H), 4096});
        xcd_barrier(gb);
    }
#else
    run_gemm<EpiStoreBlk<1>, true>(lds, c, (const bf16_t*)(wsg + G_X1B), (const bf16_t*)(ws + WS_WUP), 4096, 1024, EpiStoreBlk<1>{(bf16_t*)(wsg + G_H), 4096});
    xcd_barrier(gb);
#endif
    run_gemm<EpiStoreBlk<0>, true>(lds, c, (const bf16_t*)(wsg + G_H), (const bf16_t*)(ws + WS_WDN), 1024, 4096, EpiStoreBlk<0>{(bf16_t*)(wsg + G_HN), 1024}, 1);
    xcd_barrier(gb);
    constexpr int NPAIR = M_HALF / 2, HELP = NPAIR / 4;
    unsigned* ddone = wready + 128;
    if (c.grp == 1 && threadIdx.x == 0) (void)__hip_atomic_fetch_add(ddone, 1u, __ATOMIC_RELAXED, __HIP_MEMORY_SCOPE_AGENT);
#pragma unroll 1
    for (int run = 0; run < (c.grp == 0 ? 2 : 1); ++run) {
        if (run == 1) {
            if (threadIdx.x == 0) {
                unsigned sp = 0;
                while (__hip_atomic_load(ddone, __ATOMIC_RELAXED, __HIP_MEMORY_SCOPE_AGENT) == 0u) { __builtin_amdgcn_s_sleep(2); if (++sp > (1u << 22)) break; }
                __builtin_amdgcn_fence(__ATOMIC_ACQUIRE, "agent");
                asm volatile("s_waitcnt vmcnt(0)" ::: "memory");
            }
            __syncthreads();
        }
        const int tg = run == 1 ? 1 : c.grp;
        const int p_lo = run == 1 ? NPAIR - HELP : 0, p_hi = (c.grp == 1) ? NPAIR - HELP : NPAIR;
        phase_final(a, c, tg, p_lo, p_hi);
    }
}

extern "C" void kernel_launch(void* const* d_in, const int* in_sizes, int n_in, void* d_out, int out_size, void* d_ws, size_t ws_size, hipStream_t stream) {
    static int grid = 0;
    if (grid == 0) {
        if (n_in != 21 || in_sizes[0] != M_TOK * DM || out_size != M_TOK * DM || ws_size < WS_END) {
            fprintf(stderr, "kernel_launch: unexpected shapes (n_in %d, in0 %d, out %d, ws %zu < %zu)\n", n_in, n_in > 0 ? in_sizes[0] : -1, out_size, ws_size, (size_t)WS_END); grid = -1; return; }
        int dev = 0, cus = 0, per_cu = 0;
        (void)hipGetDevice(&dev); (void)hipDeviceGetAttribute(&cus, hipDeviceAttributeMultiprocessorCount, dev);
        if (hipFuncSetAttribute((const void*)hymba_fwd, hipFuncAttributeMaxDynamicSharedMemorySize, LDS_BYTES) != hipSuccess) fprintf(stderr, "kernel_launch: hipFuncSetAttribute failed\n");
        if (hipOccupancyMaxActiveBlocksPerMultiprocessor(&per_cu, (const void*)hymba_fwd, 512, LDS_BYTES) != hipSuccess || per_cu < 1) { fprintf(stderr, "kernel_launch: occupancy query says %d\n", per_cu); per_cu = 1; }
        (void)hipGetLastError();
        grid = cus * per_cu;
        if (grid > 256) grid = 256;
        grid &= ~15;
        if (grid < 16) { fprintf(stderr, "kernel_launch: grid %d too small\n", grid); grid = -1; return; }
    }
    if (grid < 0) return;
    Args a{};
    for (int i = 0; i < 21; ++i) a.in[i] = (const float*)d_in[i];
    a.out = (float*)d_out; a.ws = (unsigned char*)d_ws;
    a.ph_lo = 0; a.ph_hi = N_PHASES;
    if (hipMemsetAsync((unsigned char*)d_ws + WS_BAR, 0, BAR_BYTES, stream) != hipSuccess) { fprintf(stderr, "kernel_launch: memset of the barrier words failed\n"); return; }
    void* args[] = {&a};
    hipError_t e = hipLaunchCooperativeKernel((const void*)hymba_fwd, dim3(grid), dim3(512), args, LDS_BYTES, stream);
    if (e != hipSuccess) fprintf(stderr, "kernel_launch: cooperative launch failed: %s (grid %d)\n", hipGetErrorString(e), grid);
}
```
